# Optimizing an MI355X kernel written in HIP

```python
import jax
import jax.numpy as jnp
from jax import lax
import numpy as np


D_MODEL = 1024
BATCH = 4
SEQ = 4096
DEPTH = 1
DEC_BATCH = 2
DEC_SEQ = 16384
PAST_LEN = 128

GRID_W = 64
PLE_DIM = 256
NORM_EPS = 1e-6
DN_HEADS = 4
DN_HEAD_DIM = 128
DN_WIDTH = DN_HEADS * DN_HEAD_DIM
CONV_K = 5
CHUNK = 64
ATT_HEADS = 8
ATT_KV_HEADS = 2
ATT_HEAD_DIM = 64
ATT_WIDTH = ATT_HEADS * ATT_HEAD_DIM
ATT_KV_WIDTH = ATT_KV_HEADS * ATT_HEAD_DIM
Q_BLOCK = 128
ROPE_THETA = 10000.0
MIX_WIDTH = DN_WIDTH + ATT_WIDTH
IN_SIZES = (3 * DN_WIDTH, DN_WIDTH, DN_HEADS, DN_HEADS, DN_HEADS, DN_HEADS, ATT_WIDTH, ATT_KV_WIDTH, ATT_KV_WIDTH)
IN_COLS = sum(IN_SIZES)
IN_SPLITS = tuple(sum(IN_SIZES[:i + 1]) for i in range(len(IN_SIZES) - 1))
N_KEYS = 128
N_EXPERTS = N_KEYS * N_KEYS
PEER_HEADS = 8
PEER_TOPK = 16
D_KEY = 256
D_KEY_HALF = D_KEY // 2
PEER_BLOCK = 128

kernel_name = 'hymba_deltanet_gqa_peer_encoder'


def rmsnorm(x, gain):
    x32 = x.astype(jnp.float32)
    y = x32 * lax.rsqrt(jnp.mean(x32 * x32, axis=-1, keepdims=True) + NORM_EPS)
    return (y * gain.astype(jnp.float32)).astype(x.dtype)


def l2norm(x):
    return x * lax.rsqrt(jnp.sum(x * x, axis=-1, keepdims=True) + NORM_EPS)


def short_conv(x, w):
    pad = CONV_K // 2
    return lax.conv_general_dilated(x, w[:, None, :].astype(x.dtype), window_strides=(1,), padding=[(pad, pad)], dimension_numbers=('NWC', 'WIO', 'NWC'), feature_group_count=x.shape[-1])


def chunk_gated_delta(q, k, v, g, beta):
    B, T, H, dk = q.shape
    dv = v.shape[-1]
    n_chunks = T // CHUNK
    q = q * (dk ** -0.5)

    def chunks(t):
        return jnp.moveaxis(t.reshape((B, n_chunks, CHUNK) + t.shape[2:]), 3, 1)

    q, k, v, g, beta = chunks(q), chunks(k), chunks(v), chunks(g), chunks(beta)
    gc = jnp.cumsum(g, axis=-1)
    tril = jnp.tril(jnp.ones((CHUNK, CHUNK), dtype=bool))
    strict = jnp.tril(jnp.ones((CHUNK, CHUNK), dtype=bool), -1)
    diff = gc[..., :, None] - gc[..., None, :]
    decay = jnp.where(tril, jnp.exp(jnp.where(tril, diff, 0.0)), 0.0)
    kb = k * beta[..., None]
    vb = v * beta[..., None]
    lower = jnp.where(strict, jnp.einsum('bhncd,bhnsd->bhncs', kb, k) * decay, 0.0)
    rhs = jnp.concatenate([vb, kb * jnp.exp(gc)[..., None]], axis=-1)
    sol = lax.linalg.triangular_solve(lower, rhs, left_side=True, lower=True, unit_diagonal=True)
    u, w = sol[..., :dv], sol[..., dv:]
    qk_intra = jnp.where(tril, jnp.einsum('bhncd,bhnsd->bhncs', q, k) * decay, 0.0)

    def step(S, xs):
        qi, ki, ui, wi, gi, ai = xs
        v_new = ui - jnp.einsum('bhck,bhkv->bhcv', wi, S)
        o = jnp.einsum('bhck,bhkv->bhcv', qi * jnp.exp(gi)[..., None], S) + jnp.einsum('bhcs,bhsv->bhcv', ai, v_new)
        g_last = gi[..., -1]
        S = S * jnp.exp(g_last)[..., None, None] + jnp.einsum('bhck,bhcv->bhkv', ki * jnp.exp(g_last[..., None] - gi)[..., None], v_new)
        return S, o

    xs = tuple(jnp.moveaxis(t, 2, 0) for t in (q, k, u, w, gc, qk_intra))
    S0 = jnp.zeros((B, H, dk, dv), dtype=jnp.float32)
    _, o = lax.scan(step, S0, xs)
    return jnp.transpose(o, (1, 0, 3, 2, 4)).reshape(B, T, H, dv)


def deltanet_group(qkv, z, b_f, b_b, a_f, a_b, conv_w, a_log_f, a_log_b, dt_bias_f, dt_bias_b, out_norm):
    B, T, _ = qkv.shape
    f32 = jnp.float32
    qkv = jax.nn.silu(short_conv(qkv, conv_w)).astype(f32)
    q, k, v = jnp.split(qkv, 3, axis=-1)
    q = l2norm(q.reshape(B, T, DN_HEADS, DN_HEAD_DIM))
    k = l2norm(k.reshape(B, T, DN_HEADS, DN_HEAD_DIM))
    v = v.reshape(B, T, DN_HEADS, DN_HEAD_DIM)
    g_f = -jnp.exp(a_log_f.astype(f32)) * jax.nn.softplus(a_f.astype(f32) + dt_bias_f.astype(f32))
    g_b = -jnp.exp(a_log_b.astype(f32)) * jax.nn.softplus(a_b.astype(f32) + dt_bias_b.astype(f32))
    beta_f = jax.nn.sigmoid(b_f.astype(f32))
    beta_b = jax.nn.sigmoid(b_b.astype(f32))
    o_f = chunk_gated_delta(q, k, v, g_f, beta_f)
    o_b = jnp.flip(chunk_gated_delta(jnp.flip(q, 1), jnp.flip(k, 1), jnp.flip(v, 1), jnp.flip(g_b, 1), jnp.flip(beta_b, 1)), 1)
    o = rmsnorm(o_f + o_b, out_norm) * jax.nn.silu(z.astype(f32).reshape(B, T, DN_HEADS, DN_HEAD_DIM))
    return o.reshape(B, T, DN_WIDTH).astype(z.dtype)


def rope_1d(x, pos):
    d = x.shape[-1]
    inv_freq = ROPE_THETA ** (-jnp.arange(0, d, 2, dtype=jnp.float32) / d)
    ang = pos[:, None] * inv_freq[None, :]
    cos = jnp.cos(ang)[None, :, None, :]
    sin = jnp.sin(ang)[None, :, None, :]
    x1, x2 = jnp.split(x, 2, axis=-1)
    return jnp.concatenate([x1 * cos - x2 * sin, x2 * cos + x1 * sin], axis=-1)


def axial_rope(x, row_pos, col_pos):
    xr, xc = jnp.split(x.astype(jnp.float32), 2, axis=-1)
    return jnp.concatenate([rope_1d(xr, row_pos), rope_1d(xc, col_pos)], axis=-1).astype(x.dtype)


def gqa_group(q, k, v, q_norm, k_norm):
    B, T, _ = q.shape
    rows = T // GRID_W
    row_pos = jnp.repeat(jnp.arange(rows, dtype=jnp.float32), GRID_W)
    col_pos = jnp.tile(jnp.arange(GRID_W, dtype=jnp.float32), rows)
    G = ATT_HEADS // ATT_KV_HEADS
    q = axial_rope(rmsnorm(q.reshape(B, T, ATT_HEADS, ATT_HEAD_DIM), q_norm), row_pos, col_pos)
    k = axial_rope(rmsnorm(k.reshape(B, T, ATT_KV_HEADS, ATT_HEAD_DIM), k_norm), row_pos, col_pos)
    v = v.reshape(B, T, ATT_KV_HEADS, ATT_HEAD_DIM)
    n_blocks = T // Q_BLOCK
    qb = jnp.moveaxis(q.reshape(B, n_blocks, Q_BLOCK, ATT_KV_HEADS, G, ATT_HEAD_DIM), 1, 0)
    scale = ATT_HEAD_DIM ** -0.5

    def attend(qi):
        s = jnp.einsum('bqkgd,bskd->bkgqs', qi, k).astype(jnp.float32) * scale
        p = jax.nn.softmax(s, axis=-1).astype(v.dtype)
        return jnp.einsum('bkgqs,bskd->bqkgd', p, v)

    o = lax.map(attend, qb)
    return jnp.moveaxis(o, 0, 1).reshape(B, T, ATT_WIDTH)


def peer(x, w_query, keys_a, keys_b, u_emb, v_emb):
    B, T, D = x.shape
    n_tok = B * T
    xf = x.reshape(n_tok, D)
    q = jnp.einsum('nd,dk->nk', xf, w_query).astype(jnp.float32).reshape(n_tok, PEER_HEADS, 2, D_KEY_HALF)
    s_a = jnp.einsum('nhd,kd->nhk', q[:, :, 0], keys_a.astype(jnp.float32))
    s_b = jnp.einsum('nhd,kd->nhk', q[:, :, 1], keys_b.astype(jnp.float32))
    va, ia = lax.top_k(s_a, PEER_TOPK)
    vb, ib = lax.top_k(s_b, PEER_TOPK)
    cand_s = (va[..., :, None] + vb[..., None, :]).reshape(n_tok, PEER_HEADS, PEER_TOPK * PEER_TOPK)
    cand_i = (ia[..., :, None] * N_KEYS + ib[..., None, :]).reshape(n_tok, PEER_HEADS, PEER_TOPK * PEER_TOPK)
    top_s, pos = lax.top_k(cand_s, PEER_TOPK)
    idx = jnp.take_along_axis(cand_i, pos, axis=-1).reshape(n_tok, PEER_HEADS * PEER_TOPK)
    gates = jax.nn.softmax(top_s, axis=-1).reshape(n_tok, PEER_HEADS * PEER_TOPK).astype(x.dtype)
    n_blk = n_tok // PEER_BLOCK

    def block(args):
        xb, ibk, gb = args
        h = jax.nn.gelu(jnp.einsum('pd,pkd->pk', xb, u_emb[ibk]), approximate=False)
        return jnp.einsum('pk,pkd->pd', gb * h, v_emb[ibk])

    out = lax.map(block, (xf.reshape(n_blk, PEER_BLOCK, D), idx.reshape(n_blk, PEER_BLOCK, -1), gates.reshape(n_blk, PEER_BLOCK, -1)))
    return out.reshape(B, T, D)


def encoder_layer(h, p_i, attn_norm, w_in, conv_w, a_log_fwd, a_log_bwd, dt_bias_fwd, dt_bias_bwd, dn_out_norm, q_norm, k_norm, w_out, ffn_norm, peer_query, peer_keys_a, peer_keys_b, peer_u, peer_v, ple_proj, ple_norm, ple_gate):
    a = rmsnorm(h, attn_norm)
    proj = jnp.einsum('btd,dc->btc', a, w_in)
    dn_qkv, dn_z, b_f, b_b, a_f, a_b, at_q, at_k, at_v = jnp.split(proj, IN_SPLITS, axis=-1)
    dn_out = deltanet_group(dn_qkv, dn_z, b_f, b_b, a_f, a_b, conv_w, a_log_fwd, a_log_bwd, dt_bias_fwd, dt_bias_bwd, dn_out_norm)
    at_out = gqa_group(at_q, at_k, at_v, q_norm, k_norm)
    mix = jnp.concatenate([dn_out, at_out], axis=-1)
    h = h + jnp.einsum('btc,cd->btd', mix, w_out)
    h = h + peer(rmsnorm(h, ffn_norm), peer_query, peer_keys_a, peer_keys_b, peer_u, peer_v)
    ple = rmsnorm(jnp.einsum('btp,pd->btd', p_i, ple_proj), ple_norm)
    h = h + ple * jax.nn.sigmoid(jnp.einsum('btd,de->bte', h, ple_gate))
    return h


def setup_inputs(seed: int = 0) -> dict:
    key = jax.random.key(seed)
    ks = jax.random.split(key, 32)
    f32 = jnp.float32

    def nrm(k, shape, scale):
        return jax.random.normal(k, shape, f32) * scale

    def gain(k, shape):
        return 1.0 + 0.02 * jax.random.normal(k, shape, f32)

    def inv_softplus_dt(k, shape):
        dt = jnp.exp(jax.random.uniform(k, shape, f32, minval=float(np.log(1e-3)), maxval=float(np.log(1e-1))))
        return dt + jnp.log(-jnp.expm1(-dt))

    return {
        'x_prompt': nrm(ks[0], (BATCH, SEQ, D_MODEL), 1.0),
        'x_sample': nrm(ks[1], (DEC_BATCH, DEC_SEQ, D_MODEL), 1.0),
        'p_prompt': nrm(ks[2], (DEPTH, BATCH, SEQ, PLE_DIM), 1.0),
        'p_sample': nrm(ks[3], (DEPTH, DEC_BATCH, DEC_SEQ, PLE_DIM), 1.0),
        'attn_norm': gain(ks[4], (DEPTH, D_MODEL)),
        'w_in': nrm(ks[5], (DEPTH, D_MODEL, IN_COLS), D_MODEL ** -0.5),
        'conv_w': nrm(ks[6], (DEPTH, CONV_K, 3 * DN_WIDTH), CONV_K ** -0.5),
        'a_log_fwd': jnp.log(jax.random.uniform(ks[7], (DEPTH, DN_HEADS), f32, minval=1.0, maxval=16.0)),
        'a_log_bwd': jnp.log(jax.random.uniform(ks[8], (DEPTH, DN_HEADS), f32, minval=1.0, maxval=16.0)),
        'dt_bias_fwd': inv_softplus_dt(ks[9], (DEPTH, DN_HEADS)),
        'dt_bias_bwd': inv_softplus_dt(ks[10], (DEPTH, DN_HEADS)),
        'dn_out_norm': gain(ks[11], (DEPTH, DN_HEAD_DIM)),
        'q_norm': gain(ks[12], (DEPTH, ATT_HEAD_DIM)),
        'k_norm': gain(ks[13], (DEPTH, ATT_HEAD_DIM)),
        'w_out': nrm(ks[14], (DEPTH, MIX_WIDTH, D_MODEL), MIX_WIDTH ** -0.5),
        'ffn_norm': gain(ks[15], (DEPTH, D_MODEL)),
        'peer_query': nrm(ks[16], (DEPTH, D_MODEL, PEER_HEADS * D_KEY), D_MODEL ** -0.5),
        'peer_keys_a': nrm(ks[17], (DEPTH, N_KEYS, D_KEY_HALF), D_KEY_HALF ** -0.5),
        'peer_keys_b': nrm(ks[18], (DEPTH, N_KEYS, D_KEY_HALF), D_KEY_HALF ** -0.5),
        'peer_u': nrm(ks[19], (DEPTH, N_EXPERTS, D_MODEL), D_MODEL ** -0.5),
        'peer_v': nrm(ks[20], (DEPTH, N_EXPERTS, D_MODEL), D_MODEL ** -0.5),
        'ple_proj': nrm(ks[21], (DEPTH, PLE_DIM, D_MODEL), PLE_DIM ** -0.5),
        'ple_norm': gain(ks[22], (DEPTH, D_MODEL)),
        'ple_gate': nrm(ks[23], (DEPTH, D_MODEL, D_MODEL), D_MODEL ** -0.5),
        'final_norm': gain(ks[24], (D_MODEL,)),
    }


def reference(x_prompt, x_sample, p_prompt, p_sample, attn_norm, w_in, conv_w, a_log_fwd, a_log_bwd, dt_bias_fwd, dt_bias_bwd, dn_out_norm, q_norm, k_norm, w_out, ffn_norm, peer_query, peer_keys_a, peer_keys_b, peer_u, peer_v, ple_proj, ple_norm, ple_gate, final_norm):
    h_p = x_prompt
    h_s = x_sample
    for i in range(DEPTH):
        layer_w = (attn_norm[i], w_in[i], conv_w[i], a_log_fwd[i], a_log_bwd[i], dt_bias_fwd[i], dt_bias_bwd[i], dn_out_norm[i], q_norm[i], k_norm[i], w_out[i], ffn_norm[i], peer_query[i], peer_keys_a[i], peer_keys_b[i], peer_u[i], peer_v[i], ple_proj[i], ple_norm[i], ple_gate[i])
        h_p = encoder_layer(h_p, p_prompt[i], *layer_w)
        h_s = encoder_layer(h_s, p_sample[i], *layer_w)
    y_prompt = rmsnorm(h_p, final_norm)
    y_sample = rmsnorm(h_s, final_norm)
    return (y_prompt, y_sample)
```

```cpp
#include <hip/hip_runtime.h>
#include <hip/hip_cooperative_groups.h>
#include <stdint.h>
#include <stdio.h>
namespace cg = cooperative_groups;

typedef unsigned short bf16_t;
typedef __attribute__((ext_vector_type(8))) short bf16x8;
typedef __attribute__((ext_vector_type(16))) float f32x16;
typedef __attribute__((ext_vector_type(2))) float f32x2;
typedef __attribute__((ext_vector_type(2))) __bf16 bf2_t;
#define DI __device__ __forceinline__
__device__ __forceinline__ int lane_id_fresh() { unsigned z = 0; asm volatile("" : "+v"(z)); return (int)__builtin_amdgcn_mbcnt_hi(~0u, __builtin_amdgcn_mbcnt_lo(~0u, z)); }
#define TIDX (wid_ * 64 + lane_id_fresh())
#define MFMA32(a, b, c) __builtin_amdgcn_mfma_f32_32x32x16_bf16((a), (b), (c), 0, 0, 0)

#ifndef MULTI_LAUNCH
#define MULTI_LAUNCH 0
#endif
#ifndef REPEAT_MASK
#define REPEAT_MASK 0
#endif

constexpr int NT = 49152;
constexpr int NTP = 16384;
constexpr int DM = 1024;
constexpr int INC = 2832;
constexpr int INCP = 2944;
constexpr int NITEM = 3072;
constexpr size_t MiB = 1048576;
constexpr size_t OFF_WIN = 0;
constexpr size_t OFF_WOUT = 6 * MiB;
constexpr size_t OFF_PQW = 8 * MiB;
constexpr size_t OFF_PLEP = 12 * MiB;
constexpr size_t OFF_PLEG = 12 * MiB + 512 * 1024;
constexpr size_t OFF_KEYS = 14 * MiB + 512 * 1024;
constexpr size_t OFF_CTR = 15 * MiB;
constexpr size_t OFF_XB = 15 * MiB + 16384;
constexpr size_t OFF_MIXATT = 16 * MiB;
constexpr size_t OFF_PB = 64 * MiB;
constexpr size_t OFF_R1 = 88 * MiB;
constexpr size_t OFF_R2 = 136 * MiB;
constexpr size_t OFF_R3 = 184 * MiB;
constexpr size_t OFF_R4 = 232 * MiB;
constexpr size_t OFF_R5 = 280 * MiB;
constexpr size_t OFF_Z = 328 * MiB;
constexpr size_t OFF_SM = 376 * MiB;
constexpr size_t OFF_GT = 380 * MiB;
constexpr size_t OFF_R6 = 384 * MiB;
constexpr size_t OFF_PTAB = 432 * MiB;
constexpr size_t OFF_R7 = 456 * MiB;
constexpr size_t OFF_GV = 504 * MiB;
constexpr size_t OO_QR = 0;
constexpr size_t OO_KR = 48 * MiB;
constexpr size_t OO_VT = 60 * MiB;
constexpr size_t OO_WF = 72 * MiB;
constexpr size_t OO_WB = 120 * MiB;

constexpr int LDS_BYTES = 73728;

struct Params {
  const float* in[25];
  float* out;
  char* ws;
  int ph0, ph1;
  int wid, pad_;
};

DI bf16_t f2bf(float x) { unsigned u = __float_as_uint(x); u += 0x7fffu + ((u >> 16) & 1u); return (bf16_t)(u >> 16); }
DI float bf2f(bf16_t v) { return __uint_as_float(((unsigned)v) << 16); }
DI unsigned pk2(float a, float b) { f32x2 v = {a, b}; bf2_t r = __builtin_convertvector(v, bf2_t); return __builtin_bit_cast(unsigned, r); }
DI float lo2f(unsigned u) { return __uint_as_float(u << 16); }
DI float hi2f(unsigned u) { return __uint_as_float(u & 0xffff0000u); }
DI int swap23(int x) { return (x & ~12) | ((x & 4) << 1) | ((x & 8) >> 1); }
DI int crow(int reg, int h) { return (reg & 3) + 8 * (reg >> 2) + 4 * h; }
#define DPPADDSTEP(v, ctrl, rmask) v += __int_as_float(__builtin_amdgcn_update_dpp(0, __float_as_int(v), ctrl, rmask, 0xf, true))
DI float wave_sum(float v) {
  DPPADDSTEP(v, 0x111, 0xf); DPPADDSTEP(v, 0x112, 0xf); DPPADDSTEP(v, 0x114, 0xf); DPPADDSTEP(v, 0x118, 0xf);
  DPPADDSTEP(v, 0x142, 0xa); DPPADDSTEP(v, 0x143, 0xc);
  return __int_as_float(__builtin_amdgcn_readlane(__float_as_int(v), 63));
}
DI bf16x8 pack8(const f32x16& x, int s) {
  uint4 p;
  p.x = pk2(x[8 * s + 0], x[8 * s + 1]); p.y = pk2(x[8 * s + 2], x[8 * s + 3]);
  p.z = pk2(x[8 * s + 4], x[8 * s + 5]); p.w = pk2(x[8 * s + 6], x[8 * s + 7]);
  return __builtin_bit_cast(bf16x8, p);
}
DI f32x16 zero16() { f32x16 z; for (int i = 0; i < 16; i++) z[i] = 0.f; return z; }
DI const float* xrow(const Params& p, int tok) { return tok < NTP ? p.in[0] + (size_t)tok * DM : p.in[1] + (size_t)(tok - NTP) * DM; }
DI const float* prow(const Params& p, int tok) { return tok < NTP ? p.in[2] + (size_t)tok * 256 : p.in[3] + (size_t)(tok - NTP) * 256; }
DI void seq_of(int tok, int& start, int& T, int& tin) {
  if (tok < NTP) { start = tok & ~4095; T = 4096; tin = tok & 4095; }
  else { int t = tok - NTP; start = NTP + (t & ~16383); T = 16384; tin = t & 16383; }
}
#define DPPMAXSTEP(v, ctrl, rmask) v = fmaxf(v, __int_as_float(__builtin_amdgcn_update_dpp(__float_as_int(v), __float_as_int(v), ctrl, rmask, 0xf, false)))
DI float wave_max(float v) {
  DPPMAXSTEP(v, 0x111, 0xf); DPPMAXSTEP(v, 0x112, 0xf); DPPMAXSTEP(v, 0x114, 0xf); DPPMAXSTEP(v, 0x118, 0xf);
  DPPMAXSTEP(v, 0x142, 0xa); DPPMAXSTEP(v, 0x143, 0xc);
  return __int_as_float(__builtin_amdgcn_readlane(__float_as_int(v), 63));
}

DI void transpose_cvt(const float* __restrict__ src, bf16_t* __restrict__ dst, int K, int N, int NP, size_t gtid, size_t gsz) {
  const unsigned tot = (unsigned)(K >> 1) * (unsigned)NP;
  for (unsigned i = (unsigned)gtid; i < tot; i += (unsigned)gsz) {
    const unsigned k2 = i / (unsigned)NP, n = i - k2 * (unsigned)NP;
    float v0 = 0.f, v1 = 0.f;
    if ((int)n < N) { v0 = src[(size_t)(2 * k2) * N + n]; v1 = src[(size_t)(2 * k2 + 1) * N + n]; }
    *(unsigned*)(dst + (size_t)n * K + 2 * k2) = pk2(v0, v1);
  }
}
DI void norm_row_bf16(const float* __restrict__ src, const float* __restrict__ gain, bf16_t* __restrict__ dst, int lane) {
  float4 v[4];
  float ss = 0.f;
#pragma unroll
  for (int i = 0; i < 4; i++) { v[i] = ((const float4*)src)[lane + 64 * i]; ss += v[i].x * v[i].x + v[i].y * v[i].y + v[i].z * v[i].z + v[i].w * v[i].w; }
  ss = wave_sum(ss);
  float r = rsqrtf(ss * (1.f / 1024.f) + 1e-6f);
#pragma unroll
  for (int i = 0; i < 4; i++) {
    float4 g = ((const float4*)gain)[lane + 64 * i];
    uint2 o; o.x = pk2(v[i].x * r * g.x, v[i].y * r * g.y); o.y = pk2(v[i].z * r * g.z, v[i].w * r * g.w);
    ((uint2*)dst)[lane + 64 * i] = o;
  }
}
DI void norm_row2_bf16(const float* __restrict__ s0, const float* __restrict__ s1, const float* __restrict__ gain, bf16_t* __restrict__ d0, bf16_t* __restrict__ d1, int lane) {
  float4 v[4], u[4];
  float ss = 0.f, st = 0.f;
#pragma unroll
  for (int i = 0; i < 4; i++) { v[i] = ((const float4*)s0)[lane + 64 * i]; u[i] = ((const float4*)s1)[lane + 64 * i]; }
#pragma unroll
  for (int i = 0; i < 4; i++) {
    ss += v[i].x * v[i].x + v[i].y * v[i].y + v[i].z * v[i].z + v[i].w * v[i].w;
    st += u[i].x * u[i].x + u[i].y * u[i].y + u[i].z * u[i].z + u[i].w * u[i].w;
  }
  ss = wave_sum(ss); st = wave_sum(st);
  float r = rsqrtf(ss * (1.f / 1024.f) + 1e-6f), q = rsqrtf(st * (1.f / 1024.f) + 1e-6f);
#pragma unroll
  for (int i = 0; i < 4; i++) {
    float4 g = ((const float4*)gain)[lane + 64 * i];
    uint2 o; o.x = pk2(v[i].x * r * g.x, v[i].y * r * g.y); o.y = pk2(v[i].z * r * g.z, v[i].w * r * g.w);
    ((uint2*)d0)[lane + 64 * i] = o;
    uint2 o2; o2.x = pk2(u[i].x * q * g.x, u[i].y * q * g.y); o2.y = pk2(u[i].z * q * g.z, u[i].w * q * g.w);
    ((uint2*)d1)[lane + 64 * i] = o2;
  }
}
DI void phase_prep(const Params& p) {
  const int wid_ = p.wid;
  size_t gtid = (size_t)blockIdx.x * 256 + TIDX, gsz = (size_t)gridDim.x * 256;
  char* ws = p.ws;
  if (gtid < 256) ((unsigned*)(ws + OFF_CTR))[gtid] = 0u;
  transpose_cvt(p.in[5], (bf16_t*)(ws + OFF_WIN), 1024, INC, INCP, gtid, gsz);
  transpose_cvt(p.in[14], (bf16_t*)(ws + OFF_WOUT), 1024, 1024, 1024, gtid, gsz);
  transpose_cvt(p.in[16], (bf16_t*)(ws + OFF_PQW), 1024, 2048, 2048, gtid, gsz);
  transpose_cvt(p.in[21], (bf16_t*)(ws + OFF_PLEP), 256, 1024, 1024, gtid, gsz);
  transpose_cvt(p.in[23], (bf16_t*)(ws + OFF_PLEG), 1024, 1024, 1024, gtid, gsz);
  bf16_t* keys = (bf16_t*)(ws + OFF_KEYS);
  for (size_t i = gtid; i < 32768; i += gsz) keys[i] = f2bf(i < 16384 ? p.in[17][i] : p.in[18][i - 16384]);
  uint2* pb = (uint2*)(ws + OFF_PB);
  for (size_t i = gtid; i < (size_t)NT * 64; i += gsz) {
    size_t e = i * 4;
    float4 v = e < (size_t)NTP * 256 ? *(const float4*)(p.in[2] + e) : *(const float4*)(p.in[3] + (e - (size_t)NTP * 256));
    uint2 o; o.x = pk2(v.x, v.y); o.y = pk2(v.z, v.w);
    pb[i] = o;
  }
  int lane = TIDX & 63, gw = (blockIdx.x * 256 + TIDX) >> 6, nw = gridDim.x * 4;
  bf16_t* a = (bf16_t*)(ws + OFF_R1);
  for (int t = gw; t < NT; t += 2 * nw) {
    if (t + nw < NT) norm_row2_bf16(xrow(p, t), xrow(p, t + nw), p.in[4], a + (size_t)t * DM, a + (size_t)(t + nw) * DM, lane);
    else norm_row_bf16(xrow(p, t), p.in[4], a + (size_t)t * DM, lane);
  }
}

template <class Epi>
DI void gemm128(const bf16_t* __restrict__ A, int lda, const bf16_t* __restrict__ A2, int ksplit,
                const bf16_t* __restrict__ Bt, int ldb, int K, char* ldsc, int wid_, Epi epi) {
  bf16_t* L0 = (bf16_t*)ldsc;
  const int tid = TIDX, lane = tid & 63, w = tid >> 6, r = lane & 31, h = lane >> 5;
  const int wm = w >> 1, wn = w & 1;
  f32x16 acc[2][2];
#pragma unroll
  for (int i = 0; i < 2; i++)
#pragma unroll
    for (int j = 0; j < 2; j++) acc[i][j] = zero16();
  uint4 ra0, ra1, ra2, ra3, rb0, rb1, rb2, rb3;
  const int lrow = tid >> 3, lkc = (tid & 7) * 8;
#define GEMM_GLOAD(k0_) { const bf16_t* Ap = A; int kk = (k0_); if ((k0_) >= ksplit) { Ap = A2; kk = (k0_) - ksplit; } \
    const bf16_t* ap = Ap + (size_t)lrow * lda + kk + lkc; const bf16_t* bp = Bt + (size_t)lrow * ldb + (k0_) + lkc; \
    ra0 = *(const uint4*)(ap); ra1 = *(const uint4*)(ap + (size_t)32 * lda); ra2 = *(const uint4*)(ap + (size_t)64 * lda); ra3 = *(const uint4*)(ap + (size_t)96 * lda); \
    rb0 = *(const uint4*)(bp); rb1 = *(const uint4*)(bp + (size_t)32 * ldb); rb2 = *(const uint4*)(bp + (size_t)64 * ldb); rb3 = *(const uint4*)(bp + (size_t)96 * ldb); }
#define GEMM_LSTORE(buf_) { bf16_t* As_ = L0 + (buf_) * (2 * 128 * 72); bf16_t* Bs_ = As_ + 128 * 72; \
    *(uint4*)(As_ + lrow * 72 + lkc) = ra0; *(uint4*)(As_ + (lrow + 32) * 72 + lkc) = ra1; \
    *(uint4*)(As_ + (lrow + 64) * 72 + lkc) = ra2; *(uint4*)(As_ + (lrow + 96) * 72 + lkc) = ra3; \
    *(uint4*)(Bs_ + lrow * 72 + lkc) = rb0; *(uint4*)(Bs_ + (lrow + 32) * 72 + lkc) = rb1; \
    *(uint4*)(Bs_ + (lrow + 64) * 72 + lkc) = rb2; *(uint4*)(Bs_ + (lrow + 96) * 72 + lkc) = rb3; }
  const int nk = K >> 6;
  __syncthreads();
  GEMM_GLOAD(0);
  GEMM_LSTORE(0);
  if (nk > 1) GEMM_GLOAD(64);
  __syncthreads();
  for (int kt = 0; kt < nk; kt++) {
    const bf16_t* As = L0 + (kt & 1) * (2 * 128 * 72);
    const bf16_t* Bs = As + 128 * 72;
#pragma unroll
    for (int ks = 0; ks < 4; ks++) {
      bf16x8 a[2], b[2];
#pragma unroll
      for (int i = 0; i < 2; i++) a[i] = *(const bf16x8*)(As + (wm * 64 + i * 32 + r) * 72 + ks * 16 + h * 8);
#pragma unroll
      for (int j = 0; j < 2; j++) b[j] = *(const bf16x8*)(Bs + (wn * 64 + j * 32 + r) * 72 + ks * 16 + h * 8);
#pragma unroll
      for (int i = 0; i < 2; i++)
#pragma unroll
        for (int j = 0; j < 2; j++) acc[i][j] = MFMA32(a[i], b[j], acc[i][j]);
    }
    if (kt + 1 < nk) {
      GEMM_LSTORE((kt + 1) & 1);
      if (kt + 2 < nk) GEMM_GLOAD((kt + 2) * 64);
    }
    __syncthreads();
  }
  const int odd = r & 1;
#pragma unroll
  for (int i = 0; i < 2; i++)
#pragma unroll
    for (int j = 0; j < 2; j++)
#pragma unroll
      for (int m = 0; m < 8; m++) {
        const float x0 = acc[i][j][2 * m], x1 = acc[i][j][2 * m + 1];
        const float send = odd ? x0 : x1;
        const float recv = __int_as_float(__builtin_amdgcn_update_dpp(0, __float_as_int(send), 0xB1, 0xf, 0xf, false));
        const int row = wm * 64 + i * 32 + crow(2 * m, h) + odd;
        epi(row, wn * 64 + j * 32 + (r & ~1), odd ? recv : x0, odd ? x1 : recv);
      }
}

template <class Epi>
DI void gemm256(const bf16_t* __restrict__ A, int lda, const bf16_t* __restrict__ A2, int ksplit,
                const bf16_t* __restrict__ Bt, int ldb, int K, char* ldsc, int wid_, Epi epi) {
  bf16_t* L0 = (bf16_t*)ldsc;
  int tid = TIDX;
  asm volatile("" : "+v"(tid));
  const int lane = tid & 63, w = tid >> 6, r = lane & 31, h = lane >> 5;
  const int wm = w >> 1, wn = w & 1;
  f32x16 acc[4][2];
#pragma unroll
  for (int i = 0; i < 4; i++)
#pragma unroll
    for (int j = 0; j < 2; j++) acc[i][j] = zero16();
  uint4 ra0, ra1, ra2, ra3, rb0, rb1;
  const int lrow = tid >> 2, lkc = (tid & 3) * 8;
#define G256_GLOAD(k0_) { const bf16_t* Ap = A; int kk = (k0_); if ((k0_) >= ksplit) { Ap = A2; kk = (k0_) - ksplit; } \
    const bf16_t* ap = Ap + (size_t)lrow * lda + kk + lkc; const bf16_t* bp = Bt + (size_t)lrow * ldb + (k0_) + lkc; \
    ra0 = *(const uint4*)(ap); ra1 = *(const uint4*)(ap + (size_t)64 * lda); ra2 = *(const uint4*)(ap + (size_t)128 * lda); ra3 = *(const uint4*)(ap + (size_t)192 * lda); \
    rb0 = *(const uint4*)(bp); rb1 = *(const uint4*)(bp + (size_t)64 * ldb); }
#define G256_LSTORE(buf_) { bf16_t* As_ = L0 + (buf_) * (384 * 40); bf16_t* Bs_ = As_ + 256 * 40; \
    *(uint4*)(As_ + lrow * 40 + lkc) = ra0; *(uint4*)(As_ + (lrow + 64) * 40 + lkc) = ra1; \
    *(uint4*)(As_ + (lrow + 128) * 40 + lkc) = ra2; *(uint4*)(As_ + (lrow + 192) * 40 + lkc) = ra3; \
    *(uint4*)(Bs_ + lrow * 40 + lkc) = rb0; *(uint4*)(Bs_ + (lrow + 64) * 40 + lkc) = rb1; }
  const int nk = K >> 5;
  __syncthreads();
  G256_GLOAD(0);
  G256_LSTORE(0);
  if (nk > 1) G256_GLOAD(32);
  __syncthreads();
  for (int kt = 0; kt < nk; kt++) {
    const bf16_t* As = L0 + (kt & 1) * (384 * 40);
    const bf16_t* Bs = As + 256 * 40;
#pragma unroll
    for (int ks = 0; ks < 2; ks++) {
      bf16x8 a[4], b[2];
#pragma unroll
      for (int i = 0; i < 4; i++) a[i] = *(const bf16x8*)(As + (wm * 128 + i * 32 + r) * 40 + ks * 16 + h * 8);
#pragma unroll
      for (int j = 0; j < 2; j++) b[j] = *(const bf16x8*)(Bs + (wn * 64 + j * 32 + r) * 40 + ks * 16 + h * 8);
#pragma unroll
      for (int i = 0; i < 4; i++)
#pragma unroll
        for (int j = 0; j < 2; j++) acc[i][j] = MFMA32(a[i], b[j], acc[i][j]);
    }
    if (kt + 1 < nk) {
      G256_LSTORE((kt + 1) & 1);
      if (kt + 2 < nk) G256_GLOAD((kt + 2) * 32);
    }
    __syncthreads();
  }
  const int odd = r & 1;
#pragma unroll
  for (int i = 0; i < 4; i++)
#pragma unroll
    for (int j = 0; j < 2; j++)
#pragma unroll
      for (int m = 0; m < 8; m++) {
        const float x0 = acc[i][j][2 * m], x1 = acc[i][j][2 * m + 1];
        const float send = odd ? x0 : x1;
        const float recv = __int_as_float(__builtin_amdgcn_update_dpp(0, __float_as_int(send), 0xB1, 0xf, 0xf, false));
        const int row = wm * 128 + i * 32 + crow(2 * m, h) + odd;
        epi(row, wn * 64 + j * 32 + (r & ~1), odd ? recv : x0, odd ? x1 : recv);
      }
}

template <class F>
DI void gemm_tiles_xcd(unsigned* ctr, int ntn, int nmt, int wid_, F body) {
  __shared__ int s_claim;
  const int g0 = blockIdx.x & 7;
  for (int k = 0; k < 8; k++) {
    const int grp = (g0 + k) & 7;
    const int firstm = (grp * nmt) >> 3, nms = (((grp + 1) * nmt) >> 3) - firstm;
    const int total = nms * ntn;
    for (;;) {
      __syncthreads();
      if (TIDX == 0) s_claim = (int)atomicAdd(ctr + grp * 4, 1u);
      __syncthreads();
      const int u = s_claim;
      if (u >= total) break;
      body(firstm + u / ntn, u % ntn);
    }
  }
}

DI void phase_gemm1(const Params& p, char* lds) {
  const int wid_ = p.wid;
  char* ws = p.ws;
  const bf16_t* a = (const bf16_t*)(ws + OFF_R1);
  const bf16_t* wt = (const bf16_t*)(ws + OFF_WIN);
  bf16_t* qkv = (bf16_t*)(ws + OFF_R3);
  bf16_t* z = (bf16_t*)(ws + OFF_Z);
  float* sm = (float*)(ws + OFF_SM);
  bf16_t* att = (bf16_t*)(ws + OFF_R6);
  gemm_tiles_xcd((unsigned*)(ws + OFF_CTR) + 64, INCP / 128, NT / 256, wid_, [&](int mt, int nt) {
    const int m0 = mt * 256, n0 = nt * 128;
    gemm256(a + (size_t)m0 * DM, DM, a, 1 << 30, wt + (size_t)n0 * DM, DM, DM, lds, wid_, [&](int rr, int cc, float v0, float v1) {
      int row = m0 + rr, n = n0 + cc;
      if (n < 1536) *(unsigned*)(qkv + (size_t)row * 1536 + n) = pk2(v0, v1);
      else if (n < 2048) *(unsigned*)(z + (size_t)row * 512 + (n - 1536)) = pk2(v0, v1);
      else if (n < 2064) *(float2*)(sm + (size_t)row * 16 + (n - 2048)) = make_float2(v0, v1);
      else if (n < INC) *(unsigned*)(att + (size_t)row * 768 + (n - 2064)) = pk2(v0, v1);
    });
  });
}

DI void phase_d1(const Params& p) {
  const int wid_ = p.wid;
  char* ws = p.ws;
  const int lane = TIDX & 63, gw = (blockIdx.x * 256 + TIDX) >> 6, nw = gridDim.x * 4;
  const bf16_t* qkv = (const bf16_t*)(ws + OFF_R3);
  bf16_t* qd = (bf16_t*)(ws + OFF_R1);
  bf16_t* kd = (bf16_t*)(ws + OFF_R2);
  bf16_t* vd = (bf16_t*)(ws + OFF_R7);
  const float* cw = p.in[6];
  for (int it = gw; it < (NT / 16) * 12; it += nw) {
    const int strip = it / 12, seg = it % 12, tok0 = strip * 16;
    int start, T, tin0; seq_of(tok0, start, T, tin0);
    const int c = seg * 128 + 2 * lane;
    float2 wv[5];
#pragma unroll
    for (int j = 0; j < 5; j++) wv[j] = *(const float2*)(cw + j * 1536 + c);
    unsigned raw[20];
#pragma unroll
    for (int j = 0; j < 20; j++) {
      const int tp = tin0 - 2 + j;
      raw[j] = (tp >= 0 && tp < T) ? *(const unsigned*)(qkv + (size_t)(start + tp) * 1536 + c) : 0u;
    }
    const int hd = seg & 3, d = 2 * lane;
    bf16_t* dstb = (seg < 4 ? qd : (seg < 8 ? kd : vd)) + (size_t)tok0 * 512 + hd * 128 + (seg < 8 ? swap23(d) : d);
#pragma unroll
    for (int t = 0; t < 16; t++) {
      float a0 = 0.f, a1 = 0.f;
#pragma unroll
      for (int j = 0; j < 5; j++) { a0 += lo2f(raw[t + j]) * wv[j].x; a1 += hi2f(raw[t + j]) * wv[j].y; }
      a0 = a0 / (1.f + __expf(-a0)); a1 = a1 / (1.f + __expf(-a1));
      if (seg < 8) {
        float ss = wave_sum(a0 * a0 + a1 * a1);
        float rn = rsqrtf(ss + 1e-6f);
        if (seg < 4) rn *= 0.08838834764831845f;
        a0 *= rn; a1 *= rn;
      }
      *(unsigned*)(dstb + (size_t)t * 512) = pk2(a0, a1);
    }
  }
  {
    size_t gtid = (size_t)blockIdx.x * 256 + TIDX, gsz = (size_t)gridDim.x * 256;
    const float* sm = (const float*)(ws + OFF_SM);
    float* gt = (float*)(ws + OFF_GT);
    for (size_t i = gtid; i < (size_t)NT * 16; i += gsz) {
      int e = (int)(i & 15), ty = e >> 2, hd = e & 3;
      float raw = sm[i], o;
      if (ty < 2) o = 1.f / (1.f + __expf(-raw));
      else {
        float al = ty == 2 ? p.in[7][hd] : p.in[8][hd];
        float db = ty == 2 ? p.in[9][hd] : p.in[10][hd];
        float x = raw + db;
        float sp = x > 20.f ? x : log1pf(__expf(x));
        o = -__expf(al) * sp;
      }
      gt[i] = o;
    }
  }
  {
    const bf16_t* att = (const bf16_t*)(ws + OFF_R6);
    bf16_t* qr = (bf16_t*)((char*)p.out + OO_QR);
    bf16_t* kr = (bf16_t*)((char*)p.out + OO_KR);
    bf16_t* vT = (bf16_t*)((char*)p.out + OO_VT);
    const float qg = p.in[12][lane], kg = p.in[13][lane];
    const int dd = lane & 31, fi = dd & 15;
    const float invf = exp2f(-(float)fi * (13.287712379549449f / 16.f));
    for (int strip = gw; strip < NT / 16; strip += nw) {
      const int tok0 = strip * 16;
      int start, T, tin0; seq_of(tok0, start, T, tin0);
#pragma unroll 2
      for (int t = 0; t < 16; t++) {
        const int tin = tin0 + t, tok = tok0 + t;
        float pos = (lane < 32) ? (float)(tin >> 6) : (float)(tin & 63);
        float ang = pos * invf;
        float cs = __cosf(ang), sn = __sinf(ang);
        const bf16_t* src = att + (size_t)tok * 768;
#pragma unroll
        for (int hh = 0; hh < 10; hh++) {
          float x = bf2f(src[hh * 64 + lane]);
          float ss = wave_sum(x * x);
          float y = x * rsqrtf(ss * (1.f / 64.f) + 1e-6f) * (hh < 8 ? qg : kg);
          float pr = __shfl_xor(y, 16);
          float o = (dd < 16) ? y * cs - pr * sn : y * cs + pr * sn;
          if (hh < 8) qr[(size_t)tok * 512 + hh * 64 + lane] = f2bf(o * (0.125f * 1.4426950408889634f));
          else kr[(size_t)tok * 128 + (hh - 8) * 64 + lane] = f2bf(o);
        }
      }
      unsigned short vv[2][16];
#pragma unroll
      for (int t = 0; t < 16; t++) {
        const bf16_t* src = att + (size_t)(tok0 + t) * 768;
        vv[0][t] = src[640 + lane]; vv[1][t] = src[704 + lane];
      }
#pragma unroll
      for (int kv = 0; kv < 2; kv++) {
        uint4 o0, o1;
        o0.x = vv[kv][0] | ((unsigned)vv[kv][1] << 16);   o0.y = vv[kv][2] | ((unsigned)vv[kv][3] << 16);
        o0.z = vv[kv][8] | ((unsigned)vv[kv][9] << 16);   o0.w = vv[kv][10] | ((unsigned)vv[kv][11] << 16);
        o1.x = vv[kv][4] | ((unsigned)vv[kv][5] << 16);   o1.y = vv[kv][6] | ((unsigned)vv[kv][7] << 16);
        o1.z = vv[kv][12] | ((unsigned)vv[kv][13] << 16); o1.w = vv[kv][14] | ((unsigned)vv[kv][15] << 16);
        bf16_t* dst = vT + (size_t)start * 128 + (size_t)(kv * 64 + lane) * T + tin0;
        *(uint4*)dst = o0; *(uint4*)(dst + 8) = o1;
      }
    }
  }
}

template <int DIR>
DI void d2_dir(const Params& p, int cidx, int head, char* lds) {
  const int wid_ = p.wid;
  char* ws = p.ws;
  float* gcs = (float*)lds;
  float* bts = gcs + 64;
  float* egs = bts + 64;
  float* Ls = egs + 64;
  bf16_t* Ks = (bf16_t*)(Ls + 64 * 68);
  bf16_t* Vs = Ks + 64 * 136;
  bf16_t* Qs = Vs + 64 * 136;
  const int tid = TIDX, lane = tid & 63, w = tid >> 6, r = lane & 31, h = lane >> 5;
  const int tok0 = cidx * 64, item = cidx * 4 + head;
  const bf16_t* qd = (const bf16_t*)(ws + OFF_R1);
  const bf16_t* kd = (const bf16_t*)(ws + OFF_R2);
  const bf16_t* vd = (const bf16_t*)(ws + OFF_R7);
  const float* gt = (const float*)(ws + OFF_GT);
  __syncthreads();
#pragma unroll
  for (int i = 0; i < 12; i++) {
    int c = tid + 256 * i, which = c >> 10, cc = c & 1023, li = cc >> 4, kc = cc & 15;
    int oi = DIR ? 63 - li : li;
    const bf16_t* sb = which == 0 ? qd : (which == 1 ? kd : vd);
    bf16_t* db = which == 0 ? Qs : (which == 1 ? Ks : Vs);
    *(uint4*)(db + li * 136 + kc * 8) = *(const uint4*)(sb + (size_t)(tok0 + oi) * 512 + head * 128 + kc * 8);
  }
  if (tid < 64) {
    int li = tid, oi = DIR ? 63 - li : li;
    float g = gt[(size_t)(tok0 + oi) * 16 + 8 + DIR * 4 + head];
    float b = gt[(size_t)(tok0 + oi) * 16 + DIR * 4 + head];
#pragma unroll
    for (int o = 1; o < 64; o <<= 1) { float t = __shfl_up(g, o); if (li >= o) g += t; }
    gcs[li] = g; bts[li] = b; egs[li] = __expf(g);
  }
  __syncthreads();
  {
    const int bi = w >> 1, bj = w & 1;
    f32x16 kk = zero16(), qk = zero16();
#pragma unroll
    for (int ks = 0; ks < 8; ks++) {
      bf16x8 kb_ = *(const bf16x8*)(Ks + (bj * 32 + r) * 136 + ks * 16 + h * 8);
      bf16x8 ka_ = *(const bf16x8*)(Ks + (bi * 32 + r) * 136 + ks * 16 + h * 8);
      bf16x8 qa_ = *(const bf16x8*)(Qs + (bi * 32 + r) * 136 + ks * 16 + h * 8);
      kk = MFMA32(ka_, kb_, kk);
      qk = MFMA32(qa_, kb_, qk);
    }
    const int j = bj * 32 + r;
    const float gj = gcs[j];
    bf16_t* Ab = (bf16_t*)(ws + OFF_R4) + ((size_t)(DIR * NITEM + item)) * 4096;
    const int oj = DIR ? 63 - j : j;
#pragma unroll
    for (int reg = 0; reg < 16; reg++) {
      int i = bi * 32 + crow(reg, h);
      float dec = __expf(fminf(gcs[i] - gj, 0.f));
      float Lv = (j < i) ? bts[i] * kk[reg] * dec : 0.f;
      Ls[i * 68 + j] = Lv;
      float Av = (j <= i) ? qk[reg] * dec : 0.f;
      int oi = DIR ? 63 - i : i;
      Ab[oi * 64 + swap23(oj)] = f2bf(Av);
    }
  }
  __syncthreads();
  f32x2 X2[32];
#pragma unroll
  for (int k = 0; k < 32; k++) { X2[k][0] = 0.f; X2[k][1] = 0.f; }
  const int c = tid;
  const bf16_t* colp = (c < 128) ? (Vs + c) : (Ks + (c - 128));
  const bool isw = c >= 128;
#pragma unroll
  for (int i = 0; i < 64; i++) {
    float eg = egs[i];
    float rhs = bf2f(colp[i * 136]) * (isw ? eg : 1.f) * bts[i];
    f32x2 acc2 = {0.f, 0.f};
#pragma unroll
    for (int j4 = 0; j4 < i; j4 += 4) {
      float4 l = *(const float4*)(Ls + i * 68 + j4);
      f32x2 la = {l.x, l.y}, lb = {l.z, l.w};
      acc2 -= la * X2[j4 >> 1];
      if (j4 + 2 < i) acc2 -= lb * X2[(j4 >> 1) + 1];
    }
    float acc = rhs + (acc2[0] + acc2[1]);
    asm volatile("" : "+v"(acc) : : "memory");
    X2[i >> 1][i & 1] = acc;
  }
#define X(k_) X2[(k_) >> 1][(k_) & 1]
  if (c < 128) {
    bf16_t* dst = (bf16_t*)(ws + (DIR ? OFF_R6 : OFF_R5)) + (size_t)item * 8192 + c * 64;
#pragma unroll
    for (int n8 = 0; n8 < 8; n8++) {
      unsigned pkd[4];
#pragma unroll
      for (int e = 0; e < 4; e++) {
        int n0 = n8 * 8 + 2 * e, n1 = n0 + 1;
        int p0 = 32 * (n0 >> 5) + (n0 & 3) + 8 * ((n0 >> 2) & 3) + 4 * ((n0 >> 4) & 1);
        int p1 = 32 * (n1 >> 5) + (n1 & 3) + 8 * ((n1 >> 2) & 3) + 4 * ((n1 >> 4) & 1);
        pkd[e] = pk2(X(DIR ? 63 - p0 : p0), X(DIR ? 63 - p1 : p1));
      }
      uint4 o; o.x = pkd[0]; o.y = pkd[1]; o.z = pkd[2]; o.w = pkd[3];
      *(uint4*)(dst + n8 * 8) = o;
    }
  } else {
    bf16_t* dst = (bf16_t*)((char*)p.out + (DIR ? OO_WB : OO_WF)) + (size_t)item * 8192 + (c - 128);
#pragma unroll
    for (int li = 0; li < 64; li++) { int oi = DIR ? 63 - li : li; dst[oi * 128] = f2bf(-X(li)); }
  }
  if (tid < 64) {
    int li = tid, oi = DIR ? 63 - li : li;
    float* gv = (float*)(ws + OFF_GV) + (size_t)(DIR * NITEM + item) * 128;
    gv[oi] = __expf(gcs[li]);
    gv[64 + oi] = __expf(gcs[63] - gcs[li]);
  }
  if (DIR == 0) {
    int pp = tid >> 1, half = tid & 1, dk = swap23(pp);
    bf16_t* dst = (bf16_t*)(ws + OFF_R3) + (size_t)item * 8192 + dk * 64 + half * 32;
#pragma unroll
    for (int n8 = 0; n8 < 4; n8++) {
      unsigned short e[8];
#pragma unroll
      for (int q = 0; q < 8; q++) { int ns = half * 32 + n8 * 8 + q; e[q] = Ks[swap23(ns) * 136 + pp]; }
      uint4 o;
      o.x = e[0] | ((unsigned)e[1] << 16); o.y = e[2] | ((unsigned)e[3] << 16);
      o.z = e[4] | ((unsigned)e[5] << 16); o.w = e[6] | ((unsigned)e[7] << 16);
      *(uint4*)(dst + n8 * 8) = o;
    }
  }
}
#undef X
DI void phase_d2(const Params& p, char* lds) {
  const int wid_ = p.wid;
  lds += *(volatile int*)(p.ws + OFF_CTR + 8);
  for (int it = blockIdx.x; it < NITEM; it += gridDim.x) {
    int cidx = it >> 2, head = it & 3;
    d2_dir<0>(p, cidx, head, lds);
    d2_dir<1>(p, cidx, head, lds);
  }
}

DI void scan_item(const Params& p, int item, char* lds) {
  const int wid_ = p.wid;
  char* ws = p.ws;
  int seq, head, dir;
  if (item < 16) { seq = 4 + (item >> 3); head = (item >> 1) & 3; dir = item & 1; }
  else { int it = item - 16; seq = it >> 3; head = (it >> 1) & 3; dir = it & 1; }
  const int T = seq < 4 ? 4096 : 16384;
  const int start = seq < 4 ? seq * 4096 : NTP + (seq - 4) * 16384;
  const int nch = T / 64, chunk0 = start / 64;
  bf16_t* Wsm = (bf16_t*)lds;
  bf16_t* Qsm = Wsm + 64 * 136;
  bf16_t* KTs = Qsm + 64 * 136;
  bf16_t* Asm = KTs + 128 * 72;
  float* gvs = (float*)(Asm + 64 * 72);
  const int tid = TIDX, lane = tid & 63, w = tid >> 6, r = lane & 31, h = lane >> 5;
  const bf16_t* Wg = (const bf16_t*)((char*)p.out + (dir ? OO_WB : OO_WF));
  const bf16_t* qd = (const bf16_t*)(ws + OFF_R1);
  const bf16_t* kTg = (const bf16_t*)(ws + OFF_R3);
  const bf16_t* Ag = (const bf16_t*)(ws + OFF_R4) + (size_t)dir * NITEM * 4096;
  const bf16_t* Ug = (const bf16_t*)(ws + (dir ? OFF_R6 : OFF_R5));
  const float* gvg = (const float*)(ws + OFF_GV) + (size_t)dir * NITEM * 128;
  bf16_t* og = (bf16_t*)(ws + (dir ? OFF_R7 : OFF_R2));
  f32x16 S[4];
#pragma unroll
  for (int t = 0; t < 4; t++) S[t] = zero16();
  uint4 pw0, pw1, pw2, pw3, pu0, pu1, pu2, pu3;
  const int r16 = tid >> 4, c16 = (tid & 15) * 8;
  const int r8 = tid >> 3, c8 = (tid & 7) * 8;
#define SCAN_PF(step_) { const int cgp_ = chunk0 + (dir ? nch - 1 - (step_) : (step_)); const size_t ip_ = (size_t)cgp_ * 4 + head; \
    const bf16_t* wp_ = Wg + ip_ * 8192 + r16 * 128 + c16; \
    pw0 = *(const uint4*)wp_; pw1 = *(const uint4*)(wp_ + 16 * 128); pw2 = *(const uint4*)(wp_ + 32 * 128); pw3 = *(const uint4*)(wp_ + 48 * 128); \
    const bf16_t* up_ = Ug + ip_ * 8192 + (size_t)(w * 32 + r) * 64 + h * 16; \
    pu0 = *(const uint4*)up_; pu1 = *(const uint4*)(up_ + 8); pu2 = *(const uint4*)(up_ + 32); pu3 = *(const uint4*)(up_ + 40); }
  SCAN_PF(0)
  for (int step = 0; step < nch; step++) {
    const int cg_ = chunk0 + (dir ? nch - 1 - step : step);
    const size_t it4 = (size_t)cg_ * 4 + head;
    *(uint4*)(Wsm + r16 * 136 + c16) = pw0; *(uint4*)(Wsm + (r16 + 16) * 136 + c16) = pw1;
    *(uint4*)(Wsm + (r16 + 32) * 136 + c16) = pw2; *(uint4*)(Wsm + (r16 + 48) * 136 + c16) = pw3;
    f32x16 vn[2];
    vn[0][0] = lo2f(pu0.x); vn[0][1] = hi2f(pu0.x); vn[0][2] = lo2f(pu0.y); vn[0][3] = hi2f(pu0.y);
    vn[0][4] = lo2f(pu0.z); vn[0][5] = hi2f(pu0.z); vn[0][6] = lo2f(pu0.w); vn[0][7] = hi2f(pu0.w);
    vn[0][8] = lo2f(pu1.x); vn[0][9] = hi2f(pu1.x); vn[0][10] = lo2f(pu1.y); vn[0][11] = hi2f(pu1.y);
    vn[0][12] = lo2f(pu1.z); vn[0][13] = hi2f(pu1.z); vn[0][14] = lo2f(pu1.w); vn[0][15] = hi2f(pu1.w);
    vn[1][0] = lo2f(pu2.x); vn[1][1] = hi2f(pu2.x); vn[1][2] = lo2f(pu2.y); vn[1][3] = hi2f(pu2.y);
    vn[1][4] = lo2f(pu2.z); vn[1][5] = hi2f(pu2.z); vn[1][6] = lo2f(pu2.w); vn[1][7] = hi2f(pu2.w);
    vn[1][8] = lo2f(pu3.x); vn[1][9] = hi2f(pu3.x); vn[1][10] = lo2f(pu3.y); vn[1][11] = hi2f(pu3.y);
    vn[1][12] = lo2f(pu3.z); vn[1][13] = hi2f(pu3.z); vn[1][14] = lo2f(pu3.w); vn[1][15] = hi2f(pu3.w);
    uint4 pq0, pq1, pq2, pq3, pk0, pk1, pk2, pk3, pa0, pa1;
    float pgv = 0.f;
    {
      const bf16_t* qp_ = qd + (size_t)(cg_ * 64 + r16) * 512 + head * 128 + c16;
      pq0 = *(const uint4*)qp_; pq1 = *(const uint4*)(qp_ + 16 * 512); pq2 = *(const uint4*)(qp_ + 32 * 512); pq3 = *(const uint4*)(qp_ + 48 * 512);
      const bf16_t* kp_ = kTg + it4 * 8192 + r8 * 64 + c8;
      pk0 = *(const uint4*)kp_; pk1 = *(const uint4*)(kp_ + 32 * 64); pk2 = *(const uint4*)(kp_ + 64 * 64); pk3 = *(const uint4*)(kp_ + 96 * 64);
      const bf16_t* ap_ = Ag + it4 * 4096 + r8 * 64 + c8;
      pa0 = *(const uint4*)ap_; pa1 = *(const uint4*)(ap_ + 32 * 64);
      if (tid < 128) pgv = gvg[it4 * 128 + tid];
    }
    __syncthreads();
#pragma unroll
    for (int t = 0; t < 4; t++) {
#pragma unroll
      for (int s = 0; s < 2; s++) {
        const bf16x8 sb = pack8(S[t], s);
        const int ks = 2 * t + s;
#pragma unroll
        for (int b = 0; b < 2; b++) {
          bf16x8 aw = *(const bf16x8*)(Wsm + (b * 32 + r) * 136 + ks * 16 + h * 8);
          vn[b] = MFMA32(aw, sb, vn[b]);
        }
      }
    }
    __builtin_amdgcn_sched_barrier(0);
    *(uint4*)(Qsm + r16 * 136 + c16) = pq0; *(uint4*)(Qsm + (r16 + 16) * 136 + c16) = pq1;
    *(uint4*)(Qsm + (r16 + 32) * 136 + c16) = pq2; *(uint4*)(Qsm + (r16 + 48) * 136 + c16) = pq3;
    *(uint4*)(KTs + r8 * 72 + c8) = pk0; *(uint4*)(KTs + (r8 + 32) * 72 + c8) = pk1;
    *(uint4*)(KTs + (r8 + 64) * 72 + c8) = pk2; *(uint4*)(KTs + (r8 + 96) * 72 + c8) = pk3;
    *(uint4*)(Asm + r8 * 72 + c8) = pa0; *(uint4*)(Asm + (r8 + 32) * 72 + c8) = pa1;
    if (tid < 128) gvs[tid] = pgv;
    __builtin_amdgcn_sched_barrier(0);
    if (step + 1 < nch) SCAN_PF(step + 1)
    __syncthreads();
    bf16x8 vb_[4];
#pragma unroll
    for (int b = 0; b < 2; b++) { vb_[2 * b] = pack8(vn[b], 0); vb_[2 * b + 1] = pack8(vn[b], 1); }
#pragma unroll
    for (int b = 0; b < 2; b++) {
      f32x16 oq = zero16();
#pragma unroll
      for (int t = 0; t < 4; t++) {
#pragma unroll
        for (int s = 0; s < 2; s++) {
          const bf16x8 sb = pack8(S[t], s);
          bf16x8 aq = *(const bf16x8*)(Qsm + (b * 32 + r) * 136 + (2 * t + s) * 16 + h * 8);
          oq = MFMA32(aq, sb, oq);
        }
      }
#pragma unroll
      for (int reg = 0; reg < 16; reg++) oq[reg] *= gvs[32 * b + crow(reg, h)];
#pragma unroll
      for (int kp = 0; kp < 4; kp++) {
        bf16x8 aa = *(const bf16x8*)(Asm + (b * 32 + r) * 72 + kp * 16 + h * 8);
        oq = MFMA32(aa, vb_[kp], oq);
      }
      {
        bf16_t* ob = og + (size_t)(cg_ * 64 + 32 * b + 4 * h) * 512 + head * 128 + w * 32 + r;
#pragma unroll
        for (int rq = 0; rq < 4; rq++) {
          bf16_t* pb_ = ob + rq * 8 * 512;
          asm volatile("" : "+v"(pb_));
#pragma unroll
          for (int r3 = 0; r3 < 4; r3++) {
            const int reg = rq * 4 + r3;
            pb_[r3 * 512] = f2bf(oq[reg]);
            vn[b][reg] *= gvs[64 + 32 * b + crow(reg, h)];
          }
        }
      }
      __builtin_amdgcn_sched_barrier(0);
    }
#pragma unroll
    for (int b = 0; b < 2; b++) { vb_[2 * b] = pack8(vn[b], 0); vb_[2 * b + 1] = pack8(vn[b], 1); }
    const float eS = gvs[dir ? 0 : 63];
#pragma unroll
    for (int t = 0; t < 4; t++) {
#pragma unroll
      for (int reg = 0; reg < 16; reg++) S[t][reg] *= eS;
#pragma unroll
      for (int kp = 0; kp < 4; kp++) {
        bf16x8 ak = *(const bf16x8*)(KTs + (t * 32 + r) * 72 + kp * 16 + h * 8);
        S[t] = MFMA32(ak, vb_[kp], S[t]);
      }
    }
  }
}

DI void attn_item(const Params& p, int seq, int kvh, int qb, int g, char* lds) {
  const int wid_ = p.wid;
  const int hh = kvh * 4 + g;
  const int T = seq < 4 ? 4096 : 16384;
  const int start = seq < 4 ? seq * 4096 : NTP + (seq - 4) * 16384;
  bf16_t* Kl = (bf16_t*)lds;
  bf16_t* Vl = Kl + 3 * 64 * 72;
  int tid = TIDX;
  asm volatile("" : "+v"(tid));
  const int lane = tid & 63, w = tid >> 6, r = lane & 31, h = lane >> 5;
  const bf16_t* qr = (const bf16_t*)((char*)p.out + OO_QR);
  const bf16_t* kbase = (const bf16_t*)((char*)p.out + OO_KR) + (size_t)start * 128 + kvh * 64;
  const bf16_t* vbase = (const bf16_t*)((char*)p.out + OO_VT) + (size_t)start * 128 + (size_t)kvh * 64 * T;
  const int qtok = start + qb * 256 + w * 64 + r;
  bf16x8 qf[2][4];
#pragma unroll
  for (int qq = 0; qq < 2; qq++)
#pragma unroll
    for (int ks = 0; ks < 4; ks++) qf[qq][ks] = *(const bf16x8*)(qr + (size_t)(qtok + 32 * qq) * 512 + hh * 64 + ks * 16 + h * 8);
  f32x16 O[2][2];
  O[0][0] = zero16(); O[0][1] = zero16(); O[1][0] = zero16(); O[1][1] = zero16();
  float lsum0 = 0.f, lsum1 = 0.f;
  uint4 rg0, rg1, rg2, rg3;
  const int ntile = T / 64;
  const int lrow = tid >> 3, lkc = (tid & 7) * 8;
#define ATT_GLOAD(kt_) { const bf16_t* kp_ = kbase + (size_t)((kt_) * 64 + lrow) * 128 + lkc; const bf16_t* vp_ = vbase + (size_t)lrow * T + (kt_) * 64 + lkc; \
    rg0 = *(const uint4*)kp_; rg1 = *(const uint4*)(kp_ + 32 * 128); rg2 = *(const uint4*)vp_; rg3 = *(const uint4*)(vp_ + (size_t)32 * T); }
#define ATT_LSTORE(buf_) { bf16_t* kd_ = Kl + (buf_) * 64 * 72 + lrow * 72 + lkc; bf16_t* vd_ = Vl + (buf_) * 64 * 72 + lrow * 72 + lkc; \
    *(uint4*)kd_ = rg0; *(uint4*)(kd_ + 32 * 72) = rg1; *(uint4*)vd_ = rg2; *(uint4*)(vd_ + 32 * 72) = rg3; }
#define ATT_QK(S0_, S1_, Kb_, kb_) { S0_ = zero16(); S1_ = zero16(); \
    _Pragma("unroll") for (int ks = 0; ks < 4; ks++) { bf16x8 a_ = *(const bf16x8*)((Kb_) + ((kb_) * 32 + r) * 72 + ks * 16 + h * 8); \
      S0_ = MFMA32(a_, qf[0][ks], S0_); S1_ = MFMA32(a_, qf[1][ks], S1_); } }
#define ATT_SPV(S0_, S1_, Vb_, kb_) { \
    _Pragma("unroll") for (int reg = 0; reg < 16; reg++) { S0_[reg] = __builtin_amdgcn_exp2f(S0_[reg]); lsum0 += S0_[reg]; S1_[reg] = __builtin_amdgcn_exp2f(S1_[reg]); lsum1 += S1_[reg]; } \
    bf16x8 p00 = pack8(S0_, 0), p01 = pack8(S0_, 1), p10 = pack8(S1_, 0), p11 = pack8(S1_, 1); \
    _Pragma("unroll") for (int db = 0; db < 2; db++) { \
      bf16x8 a0 = *(const bf16x8*)((Vb_) + (db * 32 + r) * 72 + (kb_) * 32 + h * 8); \
      bf16x8 a1 = *(const bf16x8*)((Vb_) + (db * 32 + r) * 72 + (kb_) * 32 + 16 + h * 8); \
      O[0][db] = MFMA32(a0, p00, O[0][db]); O[1][db] = MFMA32(a0, p10, O[1][db]); \
      O[0][db] = MFMA32(a1, p01, O[0][db]); O[1][db] = MFMA32(a1, p11, O[1][db]); } }
  __syncthreads();
  ATT_GLOAD(0);
  ATT_LSTORE(0);
  ATT_GLOAD(1);
  ATT_LSTORE(1);
  __syncthreads();
  f32x16 sc0, sc1, sn0, sn1;
  ATT_QK(sc0, sc1, Kl, 0)
  int bc = 0;
  for (int kt = 0; kt < ntile; kt++) {
    const int bn = bc == 2 ? 0 : bc + 1, bw = bn == 2 ? 0 : bn + 1;
    if (kt + 2 < ntile) ATT_GLOAD(kt + 2);
    const bf16_t* Kb = Kl + bc * 64 * 72;
    const bf16_t* Vb = Vl + bc * 64 * 72;
    ATT_QK(sn0, sn1, Kb, 1)
    ATT_SPV(sc0, sc1, Vb, 0)
    if (kt + 1 < ntile) { const bf16_t* Kn = Kl + bn * 64 * 72; ATT_QK(sc0, sc1, Kn, 0) }
    ATT_SPV(sn0, sn1, Vb, 1)
    if (kt + 2 < ntile) ATT_LSTORE(bw);
    __syncthreads();
    bc = bn;
  }
  float inv0 = 1.f / (lsum0 + __shfl_xor(lsum0, 32));
  float inv1 = 1.f / (lsum1 + __shfl_xor(lsum1, 32));
  {
    int tid2 = TIDX;
    asm volatile("" : "+v"(tid2));
    const int lane2 = tid2 & 63, w2 = tid2 >> 6, r2 = lane2 & 31, h2 = lane2 >> 5;
    bf16_t* mo = (bf16_t*)(p.ws + OFF_MIXATT) + (size_t)(start + qb * 256 + w2 * 64 + r2) * 512 + hh * 64 + 4 * h2;
#pragma unroll
    for (int qq = 0; qq < 2; qq++)
#pragma unroll
      for (int db = 0; db < 2; db++)
#pragma unroll
        for (int reg = 0; reg < 16; reg++) {
          int d = db * 32 + (reg & 3) + 8 * (reg >> 2);
          mo[(size_t)(32 * qq) * 512 + d] = f2bf(O[qq][db][reg] * (qq ? inv1 : inv0));
        }
  }
}
DI void phase_scan_attn(const Params& p, char* lds) {
  const int wid_ = p.wid;
  __shared__ int s_item;
  if (blockIdx.x < 48) { scan_item(p, blockIdx.x, lds); if (REPEAT_MASK & 0x10000) { __syncthreads(); scan_item(p, blockIdx.x, lds); } }
  unsigned* ctr = (unsigned*)(p.ws + OFF_CTR) + 32;
  const int g0 = blockIdx.x & 7;
  for (int k = 0; k < 8; k++) {
    const int grp = (g0 + k) & 7;
    for (;;) {
      __syncthreads();
      if (TIDX == 0) s_item = (int)atomicAdd(ctr + grp * 4, 1u);
      __syncthreads();
      const int i = s_item;
      if (i >= 192) break;
      if (i < 128) attn_item(p, 4 + (grp >> 2), (grp >> 1) & 1, 32 * (grp & 1) + (i >> 2), i & 3, lds);
      else attn_item(p, grp >> 1, grp & 1, (i - 128) >> 2, i & 3, lds);
    }
  }
}

DI void phase_d4(const Params& p) {
  const int wid_ = p.wid;
  char* ws = p.ws;
  const int lane = TIDX & 63, gw = (blockIdx.x * 256 + TIDX) >> 6, nw = gridDim.x * 4;
  const bf16_t* of = (const bf16_t*)(ws + OFF_R2);
  const bf16_t* ob = (const bf16_t*)(ws + OFF_R7);
  const bf16_t* z = (const bf16_t*)(ws + OFF_Z);
  bf16_t* mix = (bf16_t*)(ws + OFF_R3);
  const float2 gn = *(const float2*)(p.in[11] + 2 * lane);
  for (int tok = gw; tok < NT; tok += nw) {
    unsigned uf[4], ub[4], uz[4];
#pragma unroll
    for (int hd = 0; hd < 4; hd++) {
      size_t off = (size_t)tok * 512 + hd * 128 + 2 * lane;
      uf[hd] = *(const unsigned*)(of + off); ub[hd] = *(const unsigned*)(ob + off); uz[hd] = *(const unsigned*)(z + off);
    }
#pragma unroll
    for (int hd = 0; hd < 4; hd++) {
      size_t off = (size_t)tok * 512 + hd * 128 + 2 * lane;
      float o0 = lo2f(uf[hd]) + lo2f(ub[hd]), o1 = hi2f(uf[hd]) + hi2f(ub[hd]);
      float ss = wave_sum(o0 * o0 + o1 * o1);
      float rn = rsqrtf(ss * (1.f / 128.f) + 1e-6f);
      float z0 = lo2f(uz[hd]), z1 = hi2f(uz[hd]);
      float y0 = o0 * rn * gn.x * (z0 / (1.f + __expf(-z0)));
      float y1 = o1 * rn * gn.y * (z1 / (1.f + __expf(-z1)));
      *(unsigned*)(mix + off) = pk2(y0, y1);
    }
  }
}

DI void phase_gemm2(const Params& p, char* lds) {
  const int wid_ = p.wid;
  char* ws = p.ws;
  const bf16_t* mdn = (const bf16_t*)(ws + OFF_R3);
  const bf16_t* mat = (const bf16_t*)(ws + OFF_MIXATT);
  const bf16_t* wt = (const bf16_t*)(ws + OFF_WOUT);
  gemm_tiles_xcd((unsigned*)(ws + OFF_CTR) + 96, 8, NT / 256, wid_, [&](int mt, int nt) {
    const int m0 = mt * 256, n0 = nt * 128;
    gemm256(mdn + (size_t)m0 * 512, 512, mat + (size_t)m0 * 512, 512, wt + (size_t)n0 * DM, DM, DM, lds, wid_, [&](int rr, int cc, float v0, float v1) {
      int row = m0 + rr, n = n0 + cc;
      float2 xv = *(const float2*)(xrow(p, row) + n);
      *(float2*)(p.out + (size_t)row * DM + n) = make_float2(xv.x + v0, xv.y + v1);
    });
  });
}
DI void phase_norm2(const Params& p) {
  const int wid_ = p.wid;
  int lane = TIDX & 63, gw = (blockIdx.x * 256 + TIDX) >> 6, nw = gridDim.x * 4;
  bf16_t* xn = (bf16_t*)(p.ws + OFF_R1);
  for (int t = gw; t < NT; t += 2 * nw) {
    if (t + nw < NT) norm_row2_bf16(p.out + (size_t)t * DM, p.out + (size_t)(t + nw) * DM, p.in[15], xn + (size_t)t * DM, xn + (size_t)(t + nw) * DM, lane);
    else norm_row_bf16(p.out + (size_t)t * DM, p.in[15], xn + (size_t)t * DM, lane);
  }
}
DI void phase_gemm3(const Params& p, char* lds) {
  const int wid_ = p.wid;
  char* ws = p.ws;
  const bf16_t* xn = (const bf16_t*)(ws + OFF_R1);
  const bf16_t* wt = (const bf16_t*)(ws + OFF_PQW);
  bf16_t* pq = (bf16_t*)(ws + OFF_R3);
  gemm_tiles_xcd((unsigned*)(ws + OFF_CTR) + 128, 16, NT / 256, wid_, [&](int mt, int nt) {
    const int m0 = mt * 256, n0 = nt * 128;
    gemm256(xn + (size_t)m0 * DM, DM, xn, 1 << 30, wt + (size_t)n0 * DM, DM, DM, lds, wid_, [&](int rr, int cc, float v0, float v1) {
      *(unsigned*)(pq + (size_t)(m0 + rr) * 2048 + n0 + cc) = pk2(v0, v1);
    });
  });
  {
    const int lane = TIDX & 63, gw = (blockIdx.x * 256 + TIDX) >> 6, nw = gridDim.x * 4;
    uint4* dst = (uint4*)(ws + OFF_PTAB);
    float* scl = (float*)(ws + OFF_PTAB + 32 * MiB);
    for (int rw = gw; rw < 32768; rw += nw) {
      const float4* srow = (const float4*)((rw < 16384 ? p.in[19] : p.in[20]) + (size_t)(rw & 16383) * 1024) + 4 * lane;
      float4 v0 = srow[0], v1 = srow[1], v2 = srow[2], v3 = srow[3];
      float am = fmaxf(fmaxf(fmaxf(fabsf(v0.x), fabsf(v0.y)), fmaxf(fabsf(v0.z), fabsf(v0.w))), fmaxf(fmaxf(fabsf(v1.x), fabsf(v1.y)), fmaxf(fabsf(v1.z), fabsf(v1.w))));
      am = fmaxf(am, fmaxf(fmaxf(fmaxf(fabsf(v2.x), fabsf(v2.y)), fmaxf(fabsf(v2.z), fabsf(v2.w))), fmaxf(fmaxf(fabsf(v3.x), fabsf(v3.y)), fmaxf(fabsf(v3.z), fabsf(v3.w)))));
      am = wave_max(am);
      const float sc = am > 0.f ? 440.f / am : 1.f;
      int w0 = 0, w1 = 0, w2 = 0, w3 = 0;
      w0 = __builtin_amdgcn_cvt_pk_fp8_f32(v0.x * sc, v0.y * sc, w0, false); w0 = __builtin_amdgcn_cvt_pk_fp8_f32(v0.z * sc, v0.w * sc, w0, true);
      w1 = __builtin_amdgcn_cvt_pk_fp8_f32(v1.x * sc, v1.y * sc, w1, false); w1 = __builtin_amdgcn_cvt_pk_fp8_f32(v1.z * sc, v1.w * sc, w1, true);
      w2 = __builtin_amdgcn_cvt_pk_fp8_f32(v2.x * sc, v2.y * sc, w2, false); w2 = __builtin_amdgcn_cvt_pk_fp8_f32(v2.z * sc, v2.w * sc, w2, true);
      w3 = __builtin_amdgcn_cvt_pk_fp8_f32(v3.x * sc, v3.y * sc, w3, false); w3 = __builtin_amdgcn_cvt_pk_fp8_f32(v3.z * sc, v3.w * sc, w3, true);
      uint4 o; o.x = (unsigned)w0; o.y = (unsigned)w1; o.z = (unsigned)w2; o.w = (unsigned)w3;
      dst[(size_t)rw * 64 + lane] = o;
      if (lane == 0) scl[rw] = am > 0.f ? am * (1.f / 440.f) : 1.f;
    }
  }
}

#define DPP_ROR(v, n) __int_as_float(__builtin_amdgcn_update_dpp(0, __float_as_int(v), 0x120 + (n), 0xf, 0xf, true))
DI float rowmax16(float v) {
  v = fmaxf(v, DPP_ROR(v, 8)); v = fmaxf(v, DPP_ROR(v, 4)); v = fmaxf(v, DPP_ROR(v, 2)); v = fmaxf(v, DPP_ROR(v, 1));
  return v;
}
DI float rowsum16(float v) {
  v += DPP_ROR(v, 8); v += DPP_ROR(v, 4); v += DPP_ROR(v, 2); v += DPP_ROR(v, 1);
  return v;
}
__device__ const unsigned char CAND_TAB[64] = {0, 1, 2, 3, 4, 5, 6, 7, 8, 9, 10, 11, 12, 13, 14, 15, 16, 17, 18, 19, 20, 21, 22, 23, 32, 33, 34, 35, 36, 48, 49, 50, 51, 64, 65, 66, 80, 81, 96, 97, 112, 113, 128, 144, 160, 176, 192, 208, 224, 240, 255, 255, 255, 255, 255, 255, 255, 255, 255, 255, 255, 255, 255, 255};
DI void phase_topk(const Params& p, char* lds) {
  const int wid_ = p.wid;
  char* ws = p.ws;
  float* sc = (float*)lds;
  const int tid = TIDX, lane = tid & 63, w = tid >> 6, r = lane & 31, h = lane >> 5;
  const bf16_t* pq = (const bf16_t*)(ws + OFF_R3);
  const bf16_t* keys = (const bf16_t*)(ws + OFF_KEYS);
  int* pidx = (int*)(ws + OFF_R6);
  float* pgate = (float*)(ws + OFF_R6 + 24 * MiB);
  const float NEG = -3.0e38f;
  const int nblk = NT * 8 / 32;
  bf16x8 kfa[8], kfb[8], qfa[8], qfb[8];
#pragma unroll
  for (int ks = 0; ks < 8; ks++) {
    kfa[ks] = *(const bf16x8*)(keys + (w * 32 + r) * 128 + ks * 16 + h * 8);
    kfb[ks] = *(const bf16x8*)(keys + 16384 + (w * 32 + r) * 128 + ks * 16 + h * 8);
  }
  if ((int)blockIdx.x < nblk) {
#pragma unroll
    for (int ks = 0; ks < 8; ks++) {
      qfa[ks] = *(const bf16x8*)(pq + (size_t)(blockIdx.x * 32 + r) * 256 + ks * 16 + h * 8);
      qfb[ks] = *(const bf16x8*)(pq + (size_t)(blockIdx.x * 32 + r) * 256 + 128 + ks * 16 + h * 8);
    }
  }
  for (int blk = blockIdx.x; blk < nblk; blk += gridDim.x) {
    const int m0 = blk * 32;
    __syncthreads();
    {
      f32x16 sa = zero16(), sb = zero16();
#pragma unroll
      for (int ks = 0; ks < 8; ks++) {
        sa = MFMA32(qfa[ks], kfa[ks], sa);
        sb = MFMA32(qfb[ks], kfb[ks], sb);
      }
      const int nb = blk + gridDim.x;
      if (nb < nblk) {
#pragma unroll
        for (int ks = 0; ks < 8; ks++) {
          qfa[ks] = *(const bf16x8*)(pq + (size_t)(nb * 32 + r) * 256 + ks * 16 + h * 8);
          qfb[ks] = *(const bf16x8*)(pq + (size_t)(nb * 32 + r) * 256 + 128 + ks * 16 + h * 8);
        }
      }
#pragma unroll
      for (int reg = 0; reg < 16; reg++) {
        int row = crow(reg, h);
        sc[row * 132 + w * 32 + r] = sa[reg];
        sc[32 * 132 + row * 132 + w * 32 + r] = sb[reg];
      }
    }
    __syncthreads();
    {
      const int L = lane & 15, gb = lane & 48, rw0 = w * 8 + (lane >> 4);
      unsigned keep[2][2];
#define CE(x, y) { float hi_ = fmaxf(x, y), lo_ = fminf(x, y); x = hi_; y = lo_; }
#pragma unroll
      for (int side = 0; side < 2; side++) {
        float a[2][8];
#pragma unroll
        for (int q = 0; q < 2; q++) {
#pragma unroll
          for (int s = 0; s < 8; s++) {
            unsigned u = __float_as_uint(sc[side * 32 * 132 + (rw0 + 4 * q) * 132 + L + 16 * s]);
            a[q][s] = __uint_as_float((u & 0xFFFFFF80u) | (unsigned)(127 - (L + 16 * s)));
          }
          CE(a[q][0], a[q][1]) CE(a[q][2], a[q][3]) CE(a[q][4], a[q][5]) CE(a[q][6], a[q][7])
          CE(a[q][0], a[q][2]) CE(a[q][1], a[q][3]) CE(a[q][4], a[q][6]) CE(a[q][5], a[q][7])
          CE(a[q][1], a[q][2]) CE(a[q][5], a[q][6])
          CE(a[q][0], a[q][4]) CE(a[q][1], a[q][5]) CE(a[q][2], a[q][6]) CE(a[q][3], a[q][7])
          CE(a[q][2], a[q][4]) CE(a[q][3], a[q][5])
          CE(a[q][1], a[q][2]) CE(a[q][3], a[q][4]) CE(a[q][5], a[q][6])
        }
        float kp0 = 0.f, kp1 = 0.f;
        for (int it = 0; it < 16; it++) {
          float mx0 = a[0][0], mx1 = a[1][0];
          mx0 = fmaxf(mx0, DPP_ROR(mx0, 8)); mx1 = fmaxf(mx1, DPP_ROR(mx1, 8));
          mx0 = fmaxf(mx0, DPP_ROR(mx0, 4)); mx1 = fmaxf(mx1, DPP_ROR(mx1, 4));
          mx0 = fmaxf(mx0, DPP_ROR(mx0, 2)); mx1 = fmaxf(mx1, DPP_ROR(mx1, 2));
          mx0 = fmaxf(mx0, DPP_ROR(mx0, 1)); mx1 = fmaxf(mx1, DPP_ROR(mx1, 1));
          const bool w0 = a[0][0] == mx0, w1 = a[1][0] == mx1;
#pragma unroll
          for (int s = 0; s < 7; s++) { a[0][s] = w0 ? a[0][s + 1] : a[0][s]; a[1][s] = w1 ? a[1][s + 1] : a[1][s]; }
          a[0][7] = w0 ? NEG : a[0][7]; a[1][7] = w1 ? NEG : a[1][7];
          kp0 = (L == it) ? mx0 : kp0; kp1 = (L == it) ? mx1 : kp1;
        }
        keep[0][side] = __float_as_uint(kp0); keep[1][side] = __float_as_uint(kp1);
      }
      float c[2][4]; int e[2][4];
#pragma unroll
      for (int q = 0; q < 2; q++) {
#pragma unroll
        for (int s = 0; s < 4; s++) {
          const int n = s * 16 + L;
          const int ij = CAND_TAB[n];
          unsigned ua = (unsigned)__shfl((int)keep[q][0], gb + ((ij >> 4) & 15));
          unsigned ub = (unsigned)__shfl((int)keep[q][1], gb + (ij & 15));
          float v = __uint_as_float(ua & 0xFFFFFF80u) + __uint_as_float(ub & 0xFFFFFF80u);
          v = __uint_as_float((__float_as_uint(v) & 0xFFFFFFC0u) | (unsigned)(63 - n));
          c[q][s] = (ij == 255) ? NEG : v;
          e[q][s] = (127 - (int)(ua & 127u)) * 128 + (127 - (int)(ub & 127u));
        }
      }
      float cs[2][4];
#pragma unroll
      for (int q = 0; q < 2; q++) {
        cs[q][0] = c[q][0]; cs[q][1] = c[q][1]; cs[q][2] = c[q][2]; cs[q][3] = c[q][3];
        CE(cs[q][0], cs[q][1]) CE(cs[q][2], cs[q][3]) CE(cs[q][0], cs[q][2]) CE(cs[q][1], cs[q][3]) CE(cs[q][1], cs[q][2])
      }
      float ts0 = 0.f, ts1 = 0.f;
      for (int it = 0; it < 16; it++) {
        float mx0 = cs[0][0], mx1 = cs[1][0];
        mx0 = fmaxf(mx0, DPP_ROR(mx0, 8)); mx1 = fmaxf(mx1, DPP_ROR(mx1, 8));
        mx0 = fmaxf(mx0, DPP_ROR(mx0, 4)); mx1 = fmaxf(mx1, DPP_ROR(mx1, 4));
        mx0 = fmaxf(mx0, DPP_ROR(mx0, 2)); mx1 = fmaxf(mx1, DPP_ROR(mx1, 2));
        mx0 = fmaxf(mx0, DPP_ROR(mx0, 1)); mx1 = fmaxf(mx1, DPP_ROR(mx1, 1));
        const bool w0 = cs[0][0] == mx0, w1 = cs[1][0] == mx1;
#pragma unroll
        for (int s = 0; s < 3; s++) { cs[0][s] = w0 ? cs[0][s + 1] : cs[0][s]; cs[1][s] = w1 ? cs[1][s + 1] : cs[1][s]; }
        cs[0][3] = w0 ? NEG : cs[0][3]; cs[1][3] = w1 ? NEG : cs[1][3];
        ts0 = (L == it) ? mx0 : ts0; ts1 = (L == it) ? mx1 : ts1;
      }
#pragma unroll
      for (int q = 0; q < 2; q++) {
        const unsigned tu = __float_as_uint(q ? ts1 : ts0);
        const int n = 63 - (int)(tu & 63u);
        const int e0 = __shfl(e[q][0], gb + (n & 15)), e1 = __shfl(e[q][1], gb + (n & 15)), e2 = __shfl(e[q][2], gb + (n & 15)), e3 = __shfl(e[q][3], gb + (n & 15));
        const int ns = n >> 4;
        const int te = ns == 0 ? e0 : (ns == 1 ? e1 : (ns == 2 ? e2 : e3));
        const float tc = __uint_as_float(tu & 0xFFFFFFC0u);
        const float mxr = rowmax16(tc);
        const float ev = __expf(tc - mxr);
        const float sum = rowsum16(ev);
        const size_t o = (size_t)(m0 + rw0 + 4 * q) * 16 + L;
        pidx[o] = te; pgate[o] = ev / sum;
      }
    }
  }
}

typedef __attribute__((ext_vector_type(2))) float f2v;
#define FP8_DOT4(d, wq, xo) { f2v lo_ = __builtin_amdgcn_cvt_pk_f32_fp8((int)(wq), false); f2v hi_ = __builtin_amdgcn_cvt_pk_f32_fp8((int)(wq), true); \
    d = fmaf(lo_.x, xf[(xo)], d); d = fmaf(lo_.y, xf[(xo) + 1], d); d = fmaf(hi_.x, xf[(xo) + 2], d); d = fmaf(hi_.y, xf[(xo) + 3], d); }
#define FP8_AXPY4(s, wq, xo) { f2v lo_ = __builtin_amdgcn_cvt_pk_f32_fp8((int)(wq), false); f2v hi_ = __builtin_amdgcn_cvt_pk_f32_fp8((int)(wq), true); \
    acc[(xo)] = fmaf(s, lo_.x, acc[(xo)]); acc[(xo) + 1] = fmaf(s, lo_.y, acc[(xo) + 1]); acc[(xo) + 2] = fmaf(s, hi_.x, acc[(xo) + 2]); acc[(xo) + 3] = fmaf(s, hi_.y, acc[(xo) + 3]); }
DI void gather_token(const Params& p, const int tok, const int lane) {
  char* ws = p.ws;
  const uint4* ut = (const uint4*)(ws + OFF_PTAB);
  const uint4* vt = (const uint4*)(ws + OFF_PTAB + 16 * MiB);
  const float* uscl = (const float*)(ws + OFF_PTAB + 32 * MiB);
  const float* vscl = uscl + 16384;
  const int* pidx = (const int*)(ws + OFF_R6);
  const float* pgate = (const float*)(ws + OFF_R6 + 24 * MiB);
  bf16_t* xn = (bf16_t*)(ws + OFF_R1);
  {
    float xf[16];
    {
      const uint4 x0 = ((const uint4*)(xn + (size_t)tok * DM))[2 * lane];
      const uint4 x1 = ((const uint4*)(xn + (size_t)tok * DM))[2 * lane + 1];
      xf[0] = lo2f(x0.x); xf[1] = hi2f(x0.x); xf[2] = lo2f(x0.y); xf[3] = hi2f(x0.y);
      xf[4] = lo2f(x0.z); xf[5] = hi2f(x0.z); xf[6] = lo2f(x0.w); xf[7] = hi2f(x0.w);
      xf[8] = lo2f(x1.x); xf[9] = hi2f(x1.x); xf[10] = lo2f(x1.y); xf[11] = hi2f(x1.y);
      xf[12] = lo2f(x1.z); xf[13] = hi2f(x1.z); xf[14] = lo2f(x1.w); xf[15] = hi2f(x1.w);
    }
    float acc[16];
#pragma unroll
    for (int i = 0; i < 16; i++) acc[i] = 0.f;
    const int* pix = pidx + (size_t)tok * 128 + (lane >> 3);
    const float* pgt = pgate + (size_t)tok * 128 + (lane >> 3);
    int myidx = pix[0];
    float mygate = pgt[0];
    float myus = uscl[myidx], myvs = vscl[myidx];
    uint4 ur[8], vr[8];
#pragma unroll
    for (int e = 0; e < 8; e++) ur[e] = ut[(size_t)__builtin_amdgcn_readlane(myidx, e * 8) * 64 + lane];
    for (int g2 = 0; g2 < 16; g2++) {
#pragma unroll
      for (int e = 0; e < 8; e++) vr[e] = vt[(size_t)__builtin_amdgcn_readlane(myidx, e * 8) * 64 + lane];
      int nidx = myidx; float ngate = mygate, nus = myus, nvs = myvs;
      if (g2 + 1 < 16) { nidx = pix[(g2 + 1) * 8]; ngate = pgt[(g2 + 1) * 8]; nus = uscl[nidx]; nvs = vscl[nidx]; }
      float pd[8];
#pragma unroll
      for (int e = 0; e < 8; e++) {
        float d = 0.f;
        FP8_DOT4(d, ur[e].x, 0) FP8_DOT4(d, ur[e].y, 4) FP8_DOT4(d, ur[e].z, 8) FP8_DOT4(d, ur[e].w, 12)
        pd[e] = d;
      }
      if (g2 + 1 < 16) {
#pragma unroll
        for (int e = 0; e < 8; e++) ur[e] = ut[(size_t)__builtin_amdgcn_readlane(nidx, e * 8) * 64 + lane];
      }
      float q4[4];
#pragma unroll
      for (int i = 0; i < 4; i++) {
        float send = (lane & 32) ? pd[i] : pd[i + 4];
        float keep = (lane & 32) ? pd[i + 4] : pd[i];
        q4[i] = keep + __shfl_xor(send, 32);
      }
      float q2[2];
#pragma unroll
      for (int i = 0; i < 2; i++) {
        float send = (lane & 16) ? q4[i] : q4[i + 2];
        float keep = (lane & 16) ? q4[i + 2] : q4[i];
        q2[i] = keep + __shfl_xor(send, 16);
      }
      float q1;
      {
        float send = (lane & 8) ? q2[0] : q2[1];
        float keep = (lane & 8) ? q2[1] : q2[0];
        q1 = keep + __shfl_xor(send, 8);
      }
      q1 += __shfl_xor(q1, 4); q1 += __shfl_xor(q1, 2); q1 += __shfl_xor(q1, 1);
      q1 *= myus;
      const float hval = 0.5f * q1 * (1.f + erff(q1 * 0.7071067811865476f));
      const float gh = mygate * hval * myvs;
#pragma unroll
      for (int e = 0; e < 8; e++) {
        float s = __int_as_float(__builtin_amdgcn_readlane(__float_as_int(gh), e * 8));
        FP8_AXPY4(s, vr[e].x, 0) FP8_AXPY4(s, vr[e].y, 4) FP8_AXPY4(s, vr[e].z, 8) FP8_AXPY4(s, vr[e].w, 12)
      }
      myidx = nidx; mygate = ngate; myus = nus; myvs = nvs;
    }
    float4* hp = (float4*)(p.out + (size_t)tok * DM) + 4 * lane;
    float4* hq = hp;
    float4 h0 = hp[0], h1 = hp[1], h2 = hp[2], h3 = hp[3];
    h0.x += acc[0]; h0.y += acc[1]; h0.z += acc[2]; h0.w += acc[3];
    h1.x += acc[4]; h1.y += acc[5]; h1.z += acc[6]; h1.w += acc[7];
    h2.x += acc[8]; h2.y += acc[9]; h2.z += acc[10]; h2.w += acc[11];
    h3.x += acc[12]; h3.y += acc[13]; h3.z += acc[14]; h3.w += acc[15];
    hq[0] = h0; hq[1] = h1; hq[2] = h2; hq[3] = h3;
    uint4 b0, b1;
    b0.x = pk2(h0.x, h0.y); b0.y = pk2(h0.z, h0.w); b0.z = pk2(h1.x, h1.y); b0.w = pk2(h1.z, h1.w);
    b1.x = pk2(h2.x, h2.y); b1.y = pk2(h2.z, h2.w); b1.z = pk2(h3.x, h3.y); b1.w = pk2(h3.z, h3.w);
    ((uint4*)(xn + (size_t)tok * DM))[2 * lane] = b0;
    ((uint4*)(xn + (size_t)tok * DM))[2 * lane + 1] = b1;
  }
}
DI void phase_gather(const Params& p, bool dry) {
  const int wid_ = p.wid;
  char* ws = p.ws;
  const int lane = TIDX & 63, gw = (blockIdx.x * 256 + TIDX) >> 6, nw = gridDim.x * 4;
  const uint4* ut = (const uint4*)(ws + OFF_PTAB);
  const uint4* vt = (const uint4*)(ws + OFF_PTAB + 16 * MiB);
  const float* uscl = (const float*)(ws + OFF_PTAB + 32 * MiB);
  const float* vscl = uscl + 16384;
  const int* pidx = (const int*)(ws + OFF_R6);
  const float* pgate = (const float*)(ws + OFF_R6 + 24 * MiB);
  bf16_t* xn = (bf16_t*)(ws + OFF_R1);
  for (int tok = gw; tok < NT; tok += nw) {
    float xf[16];
    {
      const uint4 x0 = ((const uint4*)(xn + (size_t)tok * DM))[2 * lane];
      const uint4 x1 = ((const uint4*)(xn + (size_t)tok * DM))[2 * lane + 1];
      xf[0] = lo2f(x0.x); xf[1] = hi2f(x0.x); xf[2] = lo2f(x0.y); xf[3] = hi2f(x0.y);
      xf[4] = lo2f(x0.z); xf[5] = hi2f(x0.z); xf[6] = lo2f(x0.w); xf[7] = hi2f(x0.w);
      xf[8] = lo2f(x1.x); xf[9] = hi2f(x1.x); xf[10] = lo2f(x1.y); xf[11] = hi2f(x1.y);
      xf[12] = lo2f(x1.z); xf[13] = hi2f(x1.z); xf[14] = lo2f(x1.w); xf[15] = hi2f(x1.w);
    }
    float acc[16];
#pragma unroll
    for (int i = 0; i < 16; i++) acc[i] = 0.f;
    const int* pix = pidx + (size_t)tok * 128 + (lane >> 3);
    const float* pgt = pgate + (size_t)tok * 128 + (lane >> 3);
    int myidx = pix[0];
    float mygate = pgt[0];
    float myus = uscl[myidx], myvs = vscl[myidx];
    uint4 ur[8], vr[8];
#pragma unroll
    for (int e = 0; e < 8; e++) ur[e] = ut[(size_t)__builtin_amdgcn_readlane(myidx, e * 8) * 64 + lane];
    for (int g2 = 0; g2 < 16; g2++) {
#pragma unroll
      for (int e = 0; e < 8; e++) vr[e] = vt[(size_t)__builtin_amdgcn_readlane(myidx, e * 8) * 64 + lane];
      int nidx = myidx; float ngate = mygate, nus = myus, nvs = myvs;
      if (g2 + 1 < 16) { nidx = pix[(g2 + 1) * 8]; ngate = pgt[(g2 + 1) * 8]; nus = uscl[nidx]; nvs = vscl[nidx]; }
      float pd[8];
#pragma unroll
      for (int e = 0; e < 8; e++) {
        float d = 0.f;
        FP8_DOT4(d, ur[e].x, 0) FP8_DOT4(d, ur[e].y, 4) FP8_DOT4(d, ur[e].z, 8) FP8_DOT4(d, ur[e].w, 12)
        pd[e] = d;
      }
      if (g2 + 1 < 16) {
#pragma unroll
        for (int e = 0; e < 8; e++) ur[e] = ut[(size_t)__builtin_amdgcn_readlane(nidx, e * 8) * 64 + lane];
      }
      float q4[4];
#pragma unroll
      for (int i = 0; i < 4; i++) {
        float send = (lane & 32) ? pd[i] : pd[i + 4];
        float keep = (lane & 32) ? pd[i + 4] : pd[i];
        q4[i] = keep + __shfl_xor(send, 32);
      }
      float q2[2];
#pragma unroll
      for (int i = 0; i < 2; i++) {
        float send = (lane & 16) ? q4[i] : q4[i + 2];
        float keep = (lane & 16) ? q4[i + 2] : q4[i];
        q2[i] = keep + __shfl_xor(send, 16);
      }
      float q1;
      {
        float send = (lane & 8) ? q2[0] : q2[1];
        float keep = (lane & 8) ? q2[1] : q2[0];
        q1 = keep + __shfl_xor(send, 8);
      }
      q1 += __shfl_xor(q1, 4); q1 += __shfl_xor(q1, 2); q1 += __shfl_xor(q1, 1);
      q1 *= myus;
      const float hval = 0.5f * q1 * (1.f + erff(q1 * 0.7071067811865476f));
      const float gh = mygate * hval * myvs;
#pragma unroll
      for (int e = 0; e < 8; e++) {
        float s = __int_as_float(__builtin_amdgcn_readlane(__float_as_int(gh), e * 8));
        FP8_AXPY4(s, vr[e].x, 0) FP8_AXPY4(s, vr[e].y, 4) FP8_AXPY4(s, vr[e].z, 8) FP8_AXPY4(s, vr[e].w, 12)
      }
      myidx = nidx; mygate = ngate; myus = nus; myvs = nvs;
    }
    float4* hp = (float4*)(p.out + (size_t)tok * DM) + 4 * lane;
    float4* hq = dry ? (float4*)(ws + OFF_R3 + (size_t)tok * DM * 4) + 4 * lane : hp;
    float4 h0 = hp[0], h1 = hp[1], h2 = hp[2], h3 = hp[3];
    h0.x += acc[0]; h0.y += acc[1]; h0.z += acc[2]; h0.w += acc[3];
    h1.x += acc[4]; h1.y += acc[5]; h1.z += acc[6]; h1.w += acc[7];
    h2.x += acc[8]; h2.y += acc[9]; h2.z += acc[10]; h2.w += acc[11];
    h3.x += acc[12]; h3.y += acc[13]; h3.z += acc[14]; h3.w += acc[15];
    hq[0] = h0; hq[1] = h1; hq[2] = h2; hq[3] = h3;
    if (dry) continue;
    uint4 b0, b1;
    b0.x = pk2(h0.x, h0.y); b0.y = pk2(h0.z, h0.w); b0.z = pk2(h1.x, h1.y); b0.w = pk2(h1.z, h1.w);
    b1.x = pk2(h2.x, h2.y); b1.y = pk2(h2.z, h2.w); b1.z = pk2(h3.x, h3.y); b1.w = pk2(h3.z, h3.w);
    ((uint4*)(xn + (size_t)tok * DM))[2 * lane] = b0;
    ((uint4*)(xn + (size_t)tok * DM))[2 * lane + 1] = b1;
  }
}

DI void phase_topk_gather(const Params& p, char* lds) {
  const int wid_ = p.wid;
  char* ws = p.ws;
  float* sc = (float*)lds;
  const int tid = TIDX, lane = tid & 63, w = tid >> 6, r = lane & 31, h = lane >> 5;
  const bf16_t* pq = (const bf16_t*)(ws + OFF_R3);
  const bf16_t* keys = (const bf16_t*)(ws + OFF_KEYS);
  int* pidx = (int*)(ws + OFF_R6);
  float* pgate = (float*)(ws + OFF_R6 + 24 * MiB);
  const float NEG = -3.0e38f;
  const int nblk = NT * 8 / 32;
  for (int blk = blockIdx.x; blk < nblk; blk += gridDim.x) {
    const int m0 = blk * 32;
    __syncthreads();
    {
      f32x16 sa = zero16(), sb = zero16();
#pragma unroll
      for (int ks = 0; ks < 8; ks++) {
        bf16x8 aa = *(const bf16x8*)(pq + (size_t)(m0 + r) * 256 + ks * 16 + h * 8);
        bf16x8 ab = *(const bf16x8*)(pq + (size_t)(m0 + r) * 256 + 128 + ks * 16 + h * 8);
        bf16x8 ba = *(const bf16x8*)(keys + (w * 32 + r) * 128 + ks * 16 + h * 8);
        bf16x8 bb = *(const bf16x8*)(keys + 16384 + (w * 32 + r) * 128 + ks * 16 + h * 8);
        sa = MFMA32(aa, ba, sa);
        sb = MFMA32(ab, bb, sb);
      }
#pragma unroll
      for (int reg = 0; reg < 16; reg++) {
        int row = crow(reg, h);
        sc[row * 132 + w * 32 + r] = sa[reg];
        sc[32 * 132 + row * 132 + w * 32 + r] = sb[reg];
      }
    }
    __syncthreads();
    {
      const int L = lane & 15, gb = lane & 48, rw0 = w * 8 + (lane >> 4);
      unsigned keep[2][2];
#define CE(x, y) { float hi_ = fmaxf(x, y), lo_ = fminf(x, y); x = hi_; y = lo_; }
#pragma unroll
      for (int side = 0; side < 2; side++) {
        float a[2][8];
#pragma unroll
        for (int q = 0; q < 2; q++) {
#pragma unroll
          for (int s = 0; s < 8; s++) {
            unsigned u = __float_as_uint(sc[side * 32 * 132 + (rw0 + 4 * q) * 132 + L + 16 * s]);
            a[q][s] = __uint_as_float((u & 0xFFFFFF80u) | (unsigned)(127 - (L + 16 * s)));
          }
          CE(a[q][0], a[q][1]) CE(a[q][2], a[q][3]) CE(a[q][4], a[q][5]) CE(a[q][6], a[q][7])
          CE(a[q][0], a[q][2]) CE(a[q][1], a[q][3]) CE(a[q][4], a[q][6]) CE(a[q][5], a[q][7])
          CE(a[q][1], a[q][2]) CE(a[q][5], a[q][6])
          CE(a[q][0], a[q][4]) CE(a[q][1], a[q][5]) CE(a[q][2], a[q][6]) CE(a[q][3], a[q][7])
          CE(a[q][2], a[q][4]) CE(a[q][3], a[q][5])
          CE(a[q][1], a[q][2]) CE(a[q][3], a[q][4]) CE(a[q][5], a[q][6])
        }
        float kp0 = 0.f, kp1 = 0.f;
        for (int it = 0; it < 16; it++) {
          float mx0 = a[0][0], mx1 = a[1][0];
          mx0 = fmaxf(mx0, DPP_ROR(mx0, 8)); mx1 = fmaxf(mx1, DPP_ROR(mx1, 8));
          mx0 = fmaxf(mx0, DPP_ROR(mx0, 4)); mx1 = fmaxf(mx1, DPP_ROR(mx1, 4));
          mx0 = fmaxf(mx0, DPP_ROR(mx0, 2)); mx1 = fmaxf(mx1, DPP_ROR(mx1, 2));
          mx0 = fmaxf(mx0, DPP_ROR(mx0, 1)); mx1 = fmaxf(mx1, DPP_ROR(mx1, 1));
          const bool w0 = a[0][0] == mx0, w1 = a[1][0] == mx1;
#pragma unroll
          for (int s = 0; s < 7; s++) { a[0][s] = w0 ? a[0][s + 1] : a[0][s]; a[1][s] = w1 ? a[1][s + 1] : a[1][s]; }
          a[0][7] = w0 ? NEG : a[0][7]; a[1][7] = w1 ? NEG : a[1][7];
          kp0 = (L == it) ? mx0 : kp0; kp1 = (L == it) ? mx1 : kp1;
        }
        keep[0][side] = __float_as_uint(kp0); keep[1][side] = __float_as_uint(kp1);
      }
      float c[2][4]; int e[2][4];
#pragma unroll
      for (int q = 0; q < 2; q++) {
#pragma unroll
        for (int s = 0; s < 4; s++) {
          const int n = s * 16 + L;
          const int ij = CAND_TAB[n];
          unsigned ua = (unsigned)__shfl((int)keep[q][0], gb + ((ij >> 4) & 15));
          unsigned ub = (unsigned)__shfl((int)keep[q][1], gb + (ij & 15));
          float v = __uint_as_float(ua & 0xFFFFFF80u) + __uint_as_float(ub & 0xFFFFFF80u);
          v = __uint_as_float((__float_as_uint(v) & 0xFFFFFFC0u) | (unsigned)(63 - n));
          c[q][s] = (ij == 255) ? NEG : v;
          e[q][s] = (127 - (int)(ua & 127u)) * 128 + (127 - (int)(ub & 127u));
        }
      }
      float cs[2][4];
#pragma unroll
      for (int q = 0; q < 2; q++) {
        cs[q][0] = c[q][0]; cs[q][1] = c[q][1]; cs[q][2] = c[q][2]; cs[q][3] = c[q][3];
        CE(cs[q][0], cs[q][1]) CE(cs[q][2], cs[q][3]) CE(cs[q][0], cs[q][2]) CE(cs[q][1], cs[q][3]) CE(cs[q][1], cs[q][2])
      }
      float ts0 = 0.f, ts1 = 0.f;
      for (int it = 0; it < 16; it++) {
        float mx0 = cs[0][0], mx1 = cs[1][0];
        mx0 = fmaxf(mx0, DPP_ROR(mx0, 8)); mx1 = fmaxf(mx1, DPP_ROR(mx1, 8));
        mx0 = fmaxf(mx0, DPP_ROR(mx0, 4)); mx1 = fmaxf(mx1, DPP_ROR(mx1, 4));
        mx0 = fmaxf(mx0, DPP_ROR(mx0, 2)); mx1 = fmaxf(mx1, DPP_ROR(mx1, 2));
        mx0 = fmaxf(mx0, DPP_ROR(mx0, 1)); mx1 = fmaxf(mx1, DPP_ROR(mx1, 1));
        const bool w0 = cs[0][0] == mx0, w1 = cs[1][0] == mx1;
#pragma unroll
        for (int s = 0; s < 3; s++) { cs[0][s] = w0 ? cs[0][s + 1] : cs[0][s]; cs[1][s] = w1 ? cs[1][s + 1] : cs[1][s]; }
        cs[0][3] = w0 ? NEG : cs[0][3]; cs[1][3] = w1 ? NEG : cs[1][3];
        ts0 = (L == it) ? mx0 : ts0; ts1 = (L == it) ? mx1 : ts1;
      }
#pragma unroll
      for (int q = 0; q < 2; q++) {
        const unsigned tu = __float_as_uint(q ? ts1 : ts0);
        const int n = 63 - (int)(tu & 63u);
        const int e0 = __shfl(e[q][0], gb + (n & 15)), e1 = __shfl(e[q][1], gb + (n & 15)), e2 = __shfl(e[q][2], gb + (n & 15)), e3 = __shfl(e[q][3], gb + (n & 15));
        const int ns = n >> 4;
        const int te = ns == 0 ? e0 : (ns == 1 ? e1 : (ns == 2 ? e2 : e3));
        const float tc = __uint_as_float(tu & 0xFFFFFFC0u);
        const float mxr = rowmax16(tc);
        const float ev = __expf(tc - mxr);
        const float sum = rowsum16(ev);
        const size_t o = (size_t)(m0 + rw0 + 4 * q) * 16 + L;
        pidx[o] = te; pgate[o] = ev / sum;
      }
    }
    __syncthreads();
    gather_token(p, blk * 4 + w, lane);
  }
}


DI void phase_ple_gemm(const Params& p, char* lds) {
  const int wid_ = p.wid;
  char* ws = p.ws;
  const bf16_t* pb = (const bf16_t*)(ws + OFF_PB);
  const bf16_t* hb = (const bf16_t*)(ws + OFF_R1);
  const bf16_t* wp = (const bf16_t*)(ws + OFF_PLEP);
  const bf16_t* wg = (const bf16_t*)(ws + OFF_PLEG);
  bf16_t* Pb = (bf16_t*)(ws + OFF_R3);
  bf16_t* Gb = (bf16_t*)(ws + OFF_R5);
  gemm_tiles_xcd((unsigned*)(ws + OFF_CTR) + 160, 8, NT / 256, wid_, [&](int mt, int nt) {
    const int m0 = mt * 256, n0 = nt * 128;
    gemm256(hb + (size_t)m0 * DM, DM, hb, 1 << 30, wg + (size_t)n0 * DM, DM, DM, lds, wid_, [&](int rr, int cc, float v0, float v1) {
      *(unsigned*)(Gb + (size_t)(m0 + rr) * DM + n0 + cc) = pk2(v0, v1);
    });
  });
  gemm_tiles_xcd((unsigned*)(ws + OFF_CTR) + 192, 8, NT / 256, wid_, [&](int mt, int nt) {
    const int m0 = mt * 256, n0 = nt * 128;
    gemm256(pb + (size_t)m0 * 256, 256, pb, 1 << 30, wp + (size_t)n0 * 256, 256, 256, lds, wid_, [&](int rr, int cc, float v0, float v1) {
      *(unsigned*)(Pb + (size_t)(m0 + rr) * DM + n0 + cc) = pk2(v0, v1);
    });
  });
}
DI void phase_final(const Params& p) {
  const int wid_ = p.wid;
  char* ws = p.ws;
  const int lane = TIDX & 63, gw = (blockIdx.x * 256 + TIDX) >> 6, nw = gridDim.x * 4;
  const bf16_t* Pb = (const bf16_t*)(ws + OFF_R3);
  const bf16_t* Gb = (const bf16_t*)(ws + OFF_R5);
  const float* pn = p.in[22];
  const float* fn = p.in[24];
  float pnr[16], fnr[16];
#pragma unroll
  for (int i = 0; i < 16; i++) { int d = (i >> 3) * 512 + 8 * lane + (i & 7); pnr[i] = pn[d]; fnr[i] = fn[d]; }
  for (int tok = gw; tok < NT; tok += nw) {
    float4* hp = (float4*)(p.out + (size_t)tok * DM);
    float hv[16], pv[16], gv[16];
#pragma unroll
    for (int q = 0; q < 2; q++) {
      uint4 pu = ((const uint4*)(Pb + (size_t)tok * DM))[q * 64 + lane];
      uint4 gu = ((const uint4*)(Gb + (size_t)tok * DM))[q * 64 + lane];
      float4 a = hp[q * 128 + 2 * lane], b = hp[q * 128 + 2 * lane + 1];
      hv[q * 8 + 0] = a.x; hv[q * 8 + 1] = a.y; hv[q * 8 + 2] = a.z; hv[q * 8 + 3] = a.w;
      hv[q * 8 + 4] = b.x; hv[q * 8 + 5] = b.y; hv[q * 8 + 6] = b.z; hv[q * 8 + 7] = b.w;
      pv[q * 8 + 0] = lo2f(pu.x); pv[q * 8 + 1] = hi2f(pu.x); pv[q * 8 + 2] = lo2f(pu.y); pv[q * 8 + 3] = hi2f(pu.y);
      pv[q * 8 + 4] = lo2f(pu.z); pv[q * 8 + 5] = hi2f(pu.z); pv[q * 8 + 6] = lo2f(pu.w); pv[q * 8 + 7] = hi2f(pu.w);
      gv[q * 8 + 0] = lo2f(gu.x); gv[q * 8 + 1] = hi2f(gu.x); gv[q * 8 + 2] = lo2f(gu.y); gv[q * 8 + 3] = hi2f(gu.y);
      gv[q * 8 + 4] = lo2f(gu.z); gv[q * 8 + 5] = hi2f(gu.z); gv[q * 8 + 6] = lo2f(gu.w); gv[q * 8 + 7] = hi2f(gu.w);
    }
    float ss = 0.f;
#pragma unroll
    for (int i = 0; i < 16; i++) ss += pv[i] * pv[i];
    ss = wave_sum(ss);
    float rp = rsqrtf(ss * (1.f / 1024.f) + 1e-6f);
    float s2 = 0.f;
#pragma unroll
    for (int i = 0; i < 16; i++) {
      float ple = pv[i] * rp * pnr[i];
      float sg = 1.f / (1.f + __expf(-gv[i]));
      hv[i] += ple * sg;
      s2 += hv[i] * hv[i];
    }
    s2 = wave_sum(s2);
    float rf = rsqrtf(s2 * (1.f / 1024.f) + 1e-6f);
#pragma unroll
    for (int q = 0; q < 2; q++) {
      float4 a, b;
      a.x = hv[q * 8 + 0] * rf * fnr[q * 8 + 0]; a.y = hv[q * 8 + 1] * rf * fnr[q * 8 + 1]; a.z = hv[q * 8 + 2] * rf * fnr[q * 8 + 2]; a.w = hv[q * 8 + 3] * rf * fnr[q * 8 + 3];
      b.x = hv[q * 8 + 4] * rf * fnr[q * 8 + 4]; b.y = hv[q * 8 + 5] * rf * fnr[q * 8 + 5]; b.z = hv[q * 8 + 6] * rf * fnr[q * 8 + 6]; b.w = hv[q * 8 + 7] * rf * fnr[q * 8 + 7];
      hp[q * 128 + 2 * lane] = a; hp[q * 128 + 2 * lane + 1] = b;
    }
  }
}

#define XB_TMO      128
#define XB_XCNT(j)  (256  + 64 * (j))
#define XB_XSUB(j)  (1280 + 64 * (j))
#define XB_XGEN(j)  (2304 + 64 * (j))
#define XB_TOP      3328
#define XB_TOPGEN   3392
#define XB_SPIN_CAP (1u << 24)
DI unsigned xb_ld(unsigned* q) { return __hip_atomic_load(q, __ATOMIC_RELAXED, __HIP_MEMORY_SCOPE_AGENT); }
DI unsigned xb_add(unsigned* q, unsigned v) { return __hip_atomic_fetch_add(q, v, __ATOMIC_RELAXED, __HIP_MEMORY_SCOPE_AGENT); }
DI unsigned xb_xcc_id() { return (unsigned)__builtin_amdgcn_s_getreg((3 << 11) | 20) & 0xFu; }
#define XB_SPIN(cond, bar) do { unsigned _sp = 0; while (cond) { __builtin_amdgcn_s_sleep(1); \
    if ((++_sp & 255u) == 0u) { if (xb_ld(&(bar)[XB_TMO])) break; if (_sp > XB_SPIN_CAP) { atomicAdd(&(bar)[XB_TMO], 1u); break; } } } } while (0)
DI void xcd_barrier_complete(unsigned* bar, unsigned x, unsigned& nloc, unsigned& nx) {
  const unsigned G = gridDim.x;
  unsigned sum, cnt, mine, sp = 0u;
  for (;;) {
    sum = 0u; cnt = 0u; mine = 0u;
#pragma unroll
    for (unsigned j = 0; j < 16; ++j) { const unsigned c = xb_ld(&bar[XB_XCNT(j)]); sum += c; cnt += (c > 0u) ? 1u : 0u; mine = (j == x) ? c : mine; }
    if (sum == G) break;
    __builtin_amdgcn_s_sleep(1);
    if ((++sp & 255u) == 0u) { if (xb_ld(&bar[XB_TMO])) break; if (sp > XB_SPIN_CAP) { atomicAdd(&bar[XB_TMO], 1u); break; } }
  }
  nloc = mine > 0u ? mine : 1u; nx = cnt > 0u ? cnt : 1u;
}
DI void grid_barrier(unsigned* bar, volatile unsigned* st, int wid_) {
  asm volatile("s_waitcnt vmcnt(0)" ::: "memory");
  __syncthreads();
  if (TIDX == 0) {
    const unsigned x = xb_xcc_id();
    __builtin_amdgcn_s_waitcnt(0);
    unsigned nloc = st[0], nx = st[1];
    if (nloc == 0u) { xcd_barrier_complete(bar, x, nloc, nx); st[0] = nloc; st[1] = nx; }
    const unsigned old = xb_add(&bar[XB_XSUB(x)], 1u);
    const unsigned gen = old / nloc;
    if (old + 1u == (gen + 1u) * nloc) {
      __builtin_amdgcn_fence(__ATOMIC_RELEASE, "agent");
      asm volatile("s_waitcnt vmcnt(0)" ::: "memory");
      const unsigned og = xb_add(&bar[XB_TOP], 1u);
      const unsigned tg = og / nx;
      if (og + 1u == (tg + 1u) * nx) xb_add(&bar[XB_TOPGEN], 1u);
      else XB_SPIN(xb_ld(&bar[XB_TOPGEN]) == tg, bar);
      __builtin_amdgcn_fence(__ATOMIC_ACQUIRE, "agent");
      xb_add(&bar[XB_XGEN(x)], 1u);
      asm volatile("s_waitcnt vmcnt(0)" ::: "memory");
    } else {
      XB_SPIN(xb_ld(&bar[XB_XGEN(x)]) == gen, bar);
      __builtin_amdgcn_fence(__ATOMIC_ACQUIRE, "agent");
      asm volatile("s_waitcnt vmcnt(0)" ::: "memory");
    }
  }
  __syncthreads();
}

constexpr int NPHASE = 13;
__global__ void __launch_bounds__(256, 2) hymba_fwd(Params pin) {
  extern __shared__ __attribute__((aligned(16))) char lds[];
  Params p = pin;
  p.wid = __builtin_amdgcn_readfirstlane((int)threadIdx.x >> 6);
#if MULTI_LAUNCH
#define RUN_PHASE(k, call) if (p.ph0 <= (k) && (k) < p.ph1) { call; }
#else
#ifndef REPEAT_MASK
#define REPEAT_MASK 0
#endif
#define RUN_PHASE(k, call) if (p.ph0 <= (k) && (k) < p.ph1) { call; if (((REPEAT_MASK & ~0x400) >> (k)) & 1) { __syncthreads(); call; } if ((k) + 1 < p.ph1) { grid_barrier((unsigned*)(p.ws + OFF_XB), (volatile unsigned*)&xb_words, p.wid); } }
#endif
  __shared__ uint4 xb_words;
  if (threadIdx.x == 0) xb_words = make_uint4(0u, 0u, 0u, 0u);
  __syncthreads();
  if (p.ph1 - p.ph0 > 1 && lane_id_fresh() == 0 && p.wid == 0) (void)xb_add((unsigned*)(p.ws + OFF_XB) + XB_XCNT(xb_xcc_id()), 1u);
  if (p.ph1 > 1000) cg::this_grid().sync();
  RUN_PHASE(0, phase_prep(p))
  RUN_PHASE(1, phase_gemm1(p, lds))
  RUN_PHASE(2, phase_d1(p))
  RUN_PHASE(3, phase_d2(p, lds))
  RUN_PHASE(4, phase_scan_attn(p, lds))
  RUN_PHASE(5, phase_d4(p))
  RUN_PHASE(6, phase_gemm2(p, lds))
  RUN_PHASE(7, phase_norm2(p))
  RUN_PHASE(8, phase_gemm3(p, lds))
  RUN_PHASE(9, phase_topk_gather(p, lds))
  RUN_PHASE(11, phase_ple_gemm(p, lds))
  RUN_PHASE(12, phase_final(p))
}

extern "C" void kernel_launch(void* const* d_in, const int* in_sizes, int n_in, void* d_out, int out_size, void* d_ws, size_t ws_size,
                              hipStream_t stream) {
  static int grid_blocks = 0;
  if (!grid_blocks) {
    int dev = 0, cus = 0, per_cu = 0;
    hipGetDevice(&dev);
    hipDeviceGetAttribute(&cus, hipDeviceAttributeMultiprocessorCount, dev);
    hipFuncSetAttribute((const void*)hymba_fwd, hipFuncAttributeMaxDynamicSharedMemorySize, LDS_BYTES);
    hipOccupancyMaxActiveBlocksPerMultiprocessor(&per_cu, (const void*)hymba_fwd, 256, LDS_BYTES);
    if (per_cu < 1) per_cu = 1;
    if (per_cu > 2) per_cu = 2;
    grid_blocks = cus * per_cu;
  }
  Params p{};
  for (int i = 0; i < 25; i++) p.in[i] = (const float*)d_in[i];
  p.out = (float*)d_out;
  p.ws = (char*)d_ws;
#if MULTI_LAUNCH
  for (int ph = 0; ph < NPHASE; ph++) {
    p.ph0 = ph; p.ph1 = ph + 1;
    hipLaunchKernelGGL(hymba_fwd, dim3(grid_blocks), dim3(256), LDS_BYTES, stream, p);
  }
#else
  p.ph0 = 0; p.ph1 = NPHASE;
  hipMemsetAsync((char*)d_ws + OFF_XB, 0, 3456 * 4, stream);
  void* args[] = {&p};
  hipError_t e = hipLaunchCooperativeKernel((const void*)hymba_fwd, dim3(grid_blocks), dim3(256), args, LDS_BYTES, stream);
  if (e != hipSuccess) fprintf(stderr, "cooperative launch failed: %s (grid %d)\n", hipGetErrorString(e), grid_blocks);
#endif
}
```

```cpp
#include <hip/hip_runtime.h>
#include <hip/hip_cooperative_groups.h>
#include <stdint.h>
#include <stdio.h>
namespace cg = cooperative_groups;

typedef unsigned short bf16_t;
typedef __attribute__((ext_vector_type(8))) short bf16x8;
typedef __attribute__((ext_vector_type(16))) float f32x16;
typedef __attribute__((ext_vector_type(2))) float f32x2;
typedef __attribute__((ext_vector_type(2))) __bf16 bf2_t;
#define DI __device__ __forceinline__
__device__ __forceinline__ int lane_id_fresh() { unsigned z = 0; asm volatile("" : "+v"(z)); return (int)__builtin_amdgcn_mbcnt_hi(~0u, __builtin_amdgcn_mbcnt_lo(~0u, z)); }
#define TIDX (wid_ * 64 + lane_id_fresh())
#define MFMA32(a, b, c) __builtin_amdgcn_mfma_f32_32x32x16_bf16((a), (b), (c), 0, 0, 0)

#ifndef MULTI_LAUNCH
#define MULTI_LAUNCH 0
#endif
#ifndef REPEAT_MASK
#define REPEAT_MASK 0
#endif

constexpr int NT = 49152;
constexpr int NTP = 16384;
constexpr int DM = 1024;
constexpr int INC = 2832;
constexpr int INCP = 2944;
constexpr int NITEM = 3072;
constexpr size_t MiB = 1048576;
constexpr size_t OFF_WIN = 0;
constexpr size_t OFF_WOUT = 6 * MiB;
constexpr size_t OFF_PQW = 8 * MiB;
constexpr size_t OFF_PLEP = 12 * MiB;
constexpr size_t OFF_PLEG = 12 * MiB + 512 * 1024;
constexpr size_t OFF_KEYS = 14 * MiB + 512 * 1024;
constexpr size_t OFF_CTR = 15 * MiB;
constexpr size_t OFF_XB = 15 * MiB + 16384;
constexpr size_t OFF_MIXATT = 16 * MiB;
constexpr size_t OFF_PB = 64 * MiB;
constexpr size_t OFF_R1 = 88 * MiB;
constexpr size_t OFF_R2 = 136 * MiB;
constexpr size_t OFF_R3 = 184 * MiB;
constexpr size_t OFF_R4 = 232 * MiB;
constexpr size_t OFF_R5 = 280 * MiB;
constexpr size_t OFF_Z = 328 * MiB;
constexpr size_t OFF_SM = 376 * MiB;
constexpr size_t OFF_GT = 380 * MiB;
constexpr size_t OFF_R6 = 384 * MiB;
constexpr size_t OFF_PTAB = 432 * MiB;
constexpr size_t OFF_R7 = 456 * MiB;
constexpr size_t OFF_GV = 504 * MiB;
constexpr size_t OO_QR = 0;
constexpr size_t OO_KR = 48 * MiB;
constexpr size_t OO_VT = 60 * MiB;
constexpr size_t OO_WF = 72 * MiB;
constexpr size_t OO_WB = 120 * MiB;

constexpr int LDS_BYTES = 73728;

struct Params {
  const float* in[25];
  float* out;
  char* ws;
  int ph0, ph1;
  int wid, pad_;
};

DI bf16_t f2bf(float x) { unsigned u = __float_as_uint(x); u += 0x7fffu + ((u >> 16) & 1u); return (bf16_t)(u >> 16); }
DI float bf2f(bf16_t v) { return __uint_as_float(((unsigned)v) << 16); }
DI unsigned pk2(float a, float b) { f32x2 v = {a, b}; bf2_t r = __builtin_convertvector(v, bf2_t); return __builtin_bit_cast(unsigned, r); }
DI float lo2f(unsigned u) { return __uint_as_float(u << 16); }
DI float hi2f(unsigned u) { return __uint_as_float(u & 0xffff0000u); }
DI int swap23(int x) { return (x & ~12) | ((x & 4) << 1) | ((x & 8) >> 1); }
DI int crow(int reg, int h) { return (reg & 3) + 8 * (reg >> 2) + 4 * h; }
#define DPPADDSTEP(v, ctrl, rmask) v += __int_as_float(__builtin_amdgcn_update_dpp(0, __float_as_int(v), ctrl, rmask, 0xf, true))
DI float wave_sum(float v) {
  DPPADDSTEP(v, 0x111, 0xf); DPPADDSTEP(v, 0x112, 0xf); DPPADDSTEP(v, 0x114, 0xf); DPPADDSTEP(v, 0x118, 0xf);
  DPPADDSTEP(v, 0x142, 0xa); DPPADDSTEP(v, 0x143, 0xc);
  return __int_as_float(__builtin_amdgcn_readlane(__float_as_int(v), 63));
}
DI bf16x8 pack8(const f32x16& x, int s) {
  uint4 p;
  p.x = pk2(x[8 * s + 0], x[8 * s + 1]); p.y = pk2(x[8 * s + 2], x[8 * s + 3]);
  p.z = pk2(x[8 * s + 4], x[8 * s + 5]); p.w = pk2(x[8 * s + 6], x[8 * s + 7]);
  return __builtin_bit_cast(bf16x8, p);
}
DI f32x16 zero16() { f32x16 z; for (int i = 0; i < 16; i++) z[i] = 0.f; return z; }
DI const float* xrow(const Params& p, int tok) { return tok < NTP ? p.in[0] + (size_t)tok * DM : p.in[1] + (size_t)(tok - NTP) * DM; }
DI const float* prow(const Params& p, int tok) { return tok < NTP ? p.in[2] + (size_t)tok * 256 : p.in[3] + (size_t)(tok - NTP) * 256; }
DI void seq_of(int tok, int& start, int& T, int& tin) {
  if (tok < NTP) { start = tok & ~4095; T = 4096; tin = tok & 4095; }
  else { int t = tok - NTP; start = NTP + (t & ~16383); T = 16384; tin = t & 16383; }
}
#define DPPMAXSTEP(v, ctrl, rmask) v = fmaxf(v, __int_as_float(__builtin_amdgcn_update_dpp(__float_as_int(v), __float_as_int(v), ctrl, rmask, 0xf, false)))
DI float wave_max(float v) {
  DPPMAXSTEP(v, 0x111, 0xf); DPPMAXSTEP(v, 0x112, 0xf); DPPMAXSTEP(v, 0x114, 0xf); DPPMAXSTEP(v, 0x118, 0xf);
  DPPMAXSTEP(v, 0x142, 0xa); DPPMAXSTEP(v, 0x143, 0xc);
  return __int_as_float(__builtin_amdgcn_readlane(__float_as_int(v), 63));
}

DI void transpose_cvt(const float* __restrict__ src, bf16_t* __restrict__ dst, int K, int N, int NP, size_t gtid, size_t gsz) {
  const unsigned tot = (unsigned)(K >> 1) * (unsigned)NP;
  for (unsigned i = (unsigned)gtid; i < tot; i += (unsigned)gsz) {
    const unsigned k2 = i / (unsigned)NP, n = i - k2 * (unsigned)NP;
    float v0 = 0.f, v1 = 0.f;
    if ((int)n < N) { v0 = src[(size_t)(2 * k2) * N + n]; v1 = src[(size_t)(2 * k2 + 1) * N + n]; }
    *(unsigned*)(dst + (size_t)n * K + 2 * k2) = pk2(v0, v1);
  }
}
DI void norm_row_bf16(const float* __restrict__ src, const float* __restrict__ gain, bf16_t* __restrict__ dst, int lane) {
  float4 v[4];
  float ss = 0.f;
#pragma unroll
  for (int i = 0; i < 4; i++) { v[i] = ((const float4*)src)[lane + 64 * i]; ss += v[i].x * v[i].x + v[i].y * v[i].y + v[i].z * v[i].z + v[i].w * v[i].w; }
  ss = wave_sum(ss);
  float r = rsqrtf(ss * (1.f / 1024.f) + 1e-6f);
#pragma unroll
  for (int i = 0; i < 4; i++) {
    float4 g = ((const float4*)gain)[lane + 64 * i];
    uint2 o; o.x = pk2(v[i].x * r * g.x, v[i].y * r * g.y); o.y = pk2(v[i].z * r * g.z, v[i].w * r * g.w);
    ((uint2*)dst)[lane + 64 * i] = o;
  }
}
DI void norm_row2_bf16(const float* __restrict__ s0, const float* __restrict__ s1, const float* __restrict__ gain, bf16_t* __restrict__ d0, bf16_t* __restrict__ d1, int lane) {
  float4 v[4], u[4];
  float ss = 0.f, st = 0.f;
#pragma unroll
  for (int i = 0; i < 4; i++) { v[i] = ((const float4*)s0)[lane + 64 * i]; u[i] = ((const float4*)s1)[lane + 64 * i]; }
#pragma unroll
  for (int i = 0; i < 4; i++) {
    ss += v[i].x * v[i].x + v[i].y * v[i].y + v[i].z * v[i].z + v[i].w * v[i].w;
    st += u[i].x * u[i].x + u[i].y * u[i].y + u[i].z * u[i].z + u[i].w * u[i].w;
  }
  ss = wave_sum(ss); st = wave_sum(st);
  float r = rsqrtf(ss * (1.f / 1024.f) + 1e-6f), q = rsqrtf(st * (1.f / 1024.f) + 1e-6f);
#pragma unroll
  for (int i = 0; i < 4; i++) {
    float4 g = ((const float4*)gain)[lane + 64 * i];
    uint2 o; o.x = pk2(v[i].x * r * g.x, v[i].y * r * g.y); o.y = pk2(v[i].z * r * g.z, v[i].w * r * g.w);
    ((uint2*)d0)[lane + 64 * i] = o;
    uint2 o2; o2.x = pk2(u[i].x * q * g.x, u[i].y * q * g.y); o2.y = pk2(u[i].z * q * g.z, u[i].w * q * g.w);
    ((uint2*)d1)[lane + 64 * i] = o2;
  }
}
DI void phase_prep(const Params& p) {
  const int wid_ = p.wid;
  size_t gtid = (size_t)blockIdx.x * 256 + TIDX, gsz = (size_t)gridDim.x * 256;
  char* ws = p.ws;
  if (gtid < 256) ((unsigned*)(ws + OFF_CTR))[gtid] = 0u;
  transpose_cvt(p.in[5], (bf16_t*)(ws + OFF_WIN), 1024, INC, INCP, gtid, gsz);
  transpose_cvt(p.in[14], (bf16_t*)(ws + OFF_WOUT), 1024, 1024, 1024, gtid, gsz);
  transpose_cvt(p.in[16], (bf16_t*)(ws + OFF_PQW), 1024, 2048, 2048, gtid, gsz);
  transpose_cvt(p.in[21], (bf16_t*)(ws + OFF_PLEP), 256, 1024, 1024, gtid, gsz);
  transpose_cvt(p.in[23], (bf16_t*)(ws + OFF_PLEG), 1024, 1024, 1024, gtid, gsz);
  bf16_t* keys = (bf16_t*)(ws + OFF_KEYS);
  for (size_t i = gtid; i < 32768; i += gsz) keys[i] = f2bf(i < 16384 ? p.in[17][i] : p.in[18][i - 16384]);
  uint2* pb = (uint2*)(ws + OFF_PB);
  for (size_t i = gtid; i < (size_t)NT * 64; i += gsz) {
    size_t e = i * 4;
    float4 v = e < (size_t)NTP * 256 ? *(const float4*)(p.in[2] + e) : *(const float4*)(p.in[3] + (e - (size_t)NTP * 256));
    uint2 o; o.x = pk2(v.x, v.y); o.y = pk2(v.z, v.w);
    pb[i] = o;
  }
  int lane = TIDX & 63, gw = (blockIdx.x * 256 + TIDX) >> 6, nw = gridDim.x * 4;
  bf16_t* a = (bf16_t*)(ws + OFF_R1);
  for (int t = gw; t < NT; t += 2 * nw) {
    if (t + nw < NT) norm_row2_bf16(xrow(p, t), xrow(p, t + nw), p.in[4], a + (size_t)t * DM, a + (size_t)(t + nw) * DM, lane);
    else norm_row_bf16(xrow(p, t), p.in[4], a + (size_t)t * DM, lane);
  }
}

template <class Epi>
DI void gemm128(const bf16_t* __restrict__ A, int lda, const bf16_t* __restrict__ A2, int ksplit,
                const bf16_t* __restrict__ Bt, int ldb, int K, char* ldsc, int wid_, Epi epi) {
  bf16_t* L0 = (bf16_t*)ldsc;
  const int tid = TIDX, lane = tid & 63, w = tid >> 6, r = lane & 31, h = lane >> 5;
  const int wm = w >> 1, wn = w & 1;
  f32x16 acc[2][2];
#pragma unroll
  for (int i = 0; i < 2; i++)
#pragma unroll
    for (int j = 0; j < 2; j++) acc[i][j] = zero16();
  uint4 ra0, ra1, ra2, ra3, rb0, rb1, rb2, rb3;
  const int lrow = tid >> 3, lkc = (tid & 7) * 8;
#define GEMM_GLOAD(k0_) { const bf16_t* Ap = A; int kk = (k0_); if ((k0_) >= ksplit) { Ap = A2; kk = (k0_) - ksplit; } \
    const bf16_t* ap = Ap + (size_t)lrow * lda + kk + lkc; const bf16_t* bp = Bt + (size_t)lrow * ldb + (k0_) + lkc; \
    ra0 = *(const uint4*)(ap); ra1 = *(const uint4*)(ap + (size_t)32 * lda); ra2 = *(const uint4*)(ap + (size_t)64 * lda); ra3 = *(const uint4*)(ap + (size_t)96 * lda); \
    rb0 = *(const uint4*)(bp); rb1 = *(const uint4*)(bp + (size_t)32 * ldb); rb2 = *(const uint4*)(bp + (size_t)64 * ldb); rb3 = *(const uint4*)(bp + (size_t)96 * ldb); }
#define GEMM_LSTORE(buf_) { bf16_t* As_ = L0 + (buf_) * (2 * 128 * 72); bf16_t* Bs_ = As_ + 128 * 72; \
    *(uint4*)(As_ + lrow * 72 + lkc) = ra0; *(uint4*)(As_ + (lrow + 32) * 72 + lkc) = ra1; \
    *(uint4*)(As_ + (lrow + 64) * 72 + lkc) = ra2; *(uint4*)(As_ + (lrow + 96) * 72 + lkc) = ra3; \
    *(uint4*)(Bs_ + lrow * 72 + lkc) = rb0; *(uint4*)(Bs_ + (lrow + 32) * 72 + lkc) = rb1; \
    *(uint4*)(Bs_ + (lrow + 64) * 72 + lkc) = rb2; *(uint4*)(Bs_ + (lrow + 96) * 72 + lkc) = rb3; }
  const int nk = K >> 6;
  __syncthreads();
  GEMM_GLOAD(0);
  GEMM_LSTORE(0);
  if (nk > 1) GEMM_GLOAD(64);
  __syncthreads();
  for (int kt = 0; kt < nk; kt++) {
    const bf16_t* As = L0 + (kt & 1) * (2 * 128 * 72);
    const bf16_t* Bs = As + 128 * 72;
#pragma unroll
    for (int ks = 0; ks < 4; ks++) {
      bf16x8 a[2], b[2];
#pragma unroll
      for (int i = 0; i < 2; i++) a[i] = *(const bf16x8*)(As + (wm * 64 + i * 32 + r) * 72 + ks * 16 + h * 8);
#pragma unroll
      for (int j = 0; j < 2; j++) b[j] = *(const bf16x8*)(Bs + (wn * 64 + j * 32 + r) * 72 + ks * 16 + h * 8);
#pragma unroll
      for (int i = 0; i < 2; i++)
#pragma unroll
        for (int j = 0; j < 2; j++) acc[i][j] = MFMA32(a[i], b[j], acc[i][j]);
    }
    if (kt + 1 < nk) {
      GEMM_LSTORE((kt + 1) & 1);
      if (kt + 2 < nk) GEMM_GLOAD((kt + 2) * 64);
    }
    __syncthreads();
  }
  const int odd = r & 1;
#pragma unroll
  for (int i = 0; i < 2; i++)
#pragma unroll
    for (int j = 0; j < 2; j++)
#pragma unroll
      for (int m = 0; m < 8; m++) {
        const float x0 = acc[i][j][2 * m], x1 = acc[i][j][2 * m + 1];
        const float send = odd ? x0 : x1;
        const float recv = __int_as_float(__builtin_amdgcn_update_dpp(0, __float_as_int(send), 0xB1, 0xf, 0xf, false));
        const int row = wm * 64 + i * 32 + crow(2 * m, h) + odd;
        epi(row, wn * 64 + j * 32 + (r & ~1), odd ? recv : x0, odd ? x1 : recv);
      }
}

template <class Epi>
DI void gemm256(const bf16_t* __restrict__ A, int lda, const bf16_t* __restrict__ A2, int ksplit,
                const bf16_t* __restrict__ Bt, int ldb, int K, char* ldsc, int wid_, Epi epi) {
  bf16_t* L0 = (bf16_t*)ldsc;
  int tid = TIDX;
  asm volatile("" : "+v"(tid));
  const int lane = tid & 63, w = tid >> 6, r = lane & 31, h = lane >> 5;
  const int wm = w >> 1, wn = w & 1;
  f32x16 acc[4][2];
#pragma unroll
  for (int i = 0; i < 4; i++)
#pragma unroll
    for (int j = 0; j < 2; j++) acc[i][j] = zero16();
  uint4 ra0, ra1, ra2, ra3, rb0, rb1;
  const int lrow = tid >> 2, lkc = (tid & 3) * 8;
#define G256_GLOAD(k0_) { const bf16_t* Ap = A; int kk = (k0_); if ((k0_) >= ksplit) { Ap = A2; kk = (k0_) - ksplit; } \
    const bf16_t* ap = Ap + (size_t)lrow * lda + kk + lkc; const bf16_t* bp = Bt + (size_t)lrow * ldb + (k0_) + lkc; \
    ra0 = *(const uint4*)(ap); ra1 = *(const uint4*)(ap + (size_t)64 * lda); ra2 = *(const uint4*)(ap + (size_t)128 * lda); ra3 = *(const uint4*)(ap + (size_t)192 * lda); \
    rb0 = *(const uint4*)(bp); rb1 = *(const uint4*)(bp + (size_t)64 * ldb); }
#define G256_LSTORE(buf_) { bf16_t* As_ = L0 + (buf_) * (384 * 40); bf16_t* Bs_ = As_ + 256 * 40; \
    *(uint4*)(As_ + lrow * 40 + lkc) = ra0; *(uint4*)(As_ + (lrow + 64) * 40 + lkc) = ra1; \
    *(uint4*)(As_ + (lrow + 128) * 40 + lkc) = ra2; *(uint4*)(As_ + (lrow + 192) * 40 + lkc) = ra3; \
    *(uint4*)(Bs_ + lrow * 40 + lkc) = rb0; *(uint4*)(Bs_ + (lrow + 64) * 40 + lkc) = rb1; }
  const int nk = K >> 5;
  __syncthreads();
  G256_GLOAD(0);
  G256_LSTORE(0);
  if (nk > 1) G256_GLOAD(32);
  __syncthreads();
  for (int kt = 0; kt < nk; kt++) {
    const bf16_t* As = L0 + (kt & 1) * (384 * 40);
    const bf16_t* Bs = As + 256 * 40;
#pragma unroll
    for (int ks = 0; ks < 2; ks++) {
      bf16x8 a[4], b[2];
#pragma unroll
      for (int i = 0; i < 4; i++) a[i] = *(const bf16x8*)(As + (wm * 128 + i * 32 + r) * 40 + ks * 16 + h * 8);
#pragma unroll
      for (int j = 0; j < 2; j++) b[j] = *(const bf16x8*)(Bs + (wn * 64 + j * 32 + r) * 40 + ks * 16 + h * 8);
#pragma unroll
      for (int i = 0; i < 4; i++)
#pragma unroll
        for (int j = 0; j < 2; j++) acc[i][j] = MFMA32(a[i], b[j], acc[i][j]);
    }
    if (kt + 1 < nk) {
      G256_LSTORE((kt + 1) & 1);
      if (kt + 2 < nk) G256_GLOAD((kt + 2) * 32);
    }
    __syncthreads();
  }
  const int odd = r & 1;
#pragma unroll
  for (int i = 0; i < 4; i++)
#pragma unroll
    for (int j = 0; j < 2; j++)
#pragma unroll
      for (int m = 0; m < 8; m++) {
        const float x0 = acc[i][j][2 * m], x1 = acc[i][j][2 * m + 1];
        const float send = odd ? x0 : x1;
        const float recv = __int_as_float(__builtin_amdgcn_update_dpp(0, __float_as_int(send), 0xB1, 0xf, 0xf, false));
        const int row = wm * 128 + i * 32 + crow(2 * m, h) + odd;
        epi(row, wn * 64 + j * 32 + (r & ~1), odd ? recv : x0, odd ? x1 : recv);
      }
}

template <class F>
DI void gemm_tiles_xcd(unsigned* ctr, int ntn, int nmt, int wid_, F body) {
  __shared__ int s_claim;
  const int g0 = blockIdx.x & 7;
  for (int k = 0; k < 8; k++) {
    const int grp = (g0 + k) & 7;
    const int firstm = (grp * nmt) >> 3, nms = (((grp + 1) * nmt) >> 3) - firstm;
    const int total = nms * ntn;
    for (;;) {
      __syncthreads();
      if (TIDX == 0) s_claim = (int)atomicAdd(ctr + grp * 4, 1u);
      __syncthreads();
      const int u = s_claim;
      if (u >= total) break;
      body(firstm + u / ntn, u % ntn);
    }
  }
}

DI void phase_gemm1(const Params& p, char* lds) {
  const int wid_ = p.wid;
  char* ws = p.ws;
  const bf16_t* a = (const bf16_t*)(ws + OFF_R1);
  const bf16_t* wt = (const bf16_t*)(ws + OFF_WIN);
  bf16_t* qkv = (bf16_t*)(ws + OFF_R3);
  bf16_t* z = (bf16_t*)(ws + OFF_Z);
  float* sm = (float*)(ws + OFF_SM);
  bf16_t* att = (bf16_t*)(ws + OFF_R6);
  gemm_tiles_xcd((unsigned*)(ws + OFF_CTR) + 64, INCP / 128, NT / 256, wid_, [&](int mt, int nt) {
    const int m0 = mt * 256, n0 = nt * 128;
    gemm256(a + (size_t)m0 * DM, DM, a, 1 << 30, wt + (size_t)n0 * DM, DM, DM, lds, wid_, [&](int rr, int cc, float v0, float v1) {
      int row = m0 + rr, n = n0 + cc;
      if (n < 1536) *(unsigned*)(qkv + (size_t)row * 1536 + n) = pk2(v0, v1);
      else if (n < 2048) *(unsigned*)(z + (size_t)row * 512 + (n - 1536)) = pk2(v0, v1);
      else if (n < 2064) *(float2*)(sm + (size_t)row * 16 + (n - 2048)) = make_float2(v0, v1);
      else if (n < INC) *(unsigned*)(att + (size_t)row * 768 + (n - 2064)) = pk2(v0, v1);
    });
  });
}

DI void phase_d1(const Params& p) {
  const int wid_ = p.wid;
  char* ws = p.ws;
  const int lane = TIDX & 63, gw = (blockIdx.x * 256 + TIDX) >> 6, nw = gridDim.x * 4;
  const bf16_t* qkv = (const bf16_t*)(ws + OFF_R3);
  bf16_t* qd = (bf16_t*)(ws + OFF_R1);
  bf16_t* kd = (bf16_t*)(ws + OFF_R2);
  bf16_t* vd = (bf16_t*)(ws + OFF_R7);
  const float* cw = p.in[6];
  for (int it = gw; it < (NT / 16) * 12; it += nw) {
    const int strip = it / 12, seg = it % 12, tok0 = strip * 16;
    int start, T, tin0; seq_of(tok0, start, T, tin0);
    const int c = seg * 128 + 2 * lane;
    float2 wv[5];
#pragma unroll
    for (int j = 0; j < 5; j++) wv[j] = *(const float2*)(cw + j * 1536 + c);
    unsigned raw[20];
#pragma unroll
    for (int j = 0; j < 20; j++) {
      const int tp = tin0 - 2 + j;
      raw[j] = (tp >= 0 && tp < T) ? *(const unsigned*)(qkv + (size_t)(start + tp) * 1536 + c) : 0u;
    }
    const int hd = seg & 3, d = 2 * lane;
    bf16_t* dstb = (seg < 4 ? qd : (seg < 8 ? kd : vd)) + (size_t)tok0 * 512 + hd * 128 + (seg < 8 ? swap23(d) : d);
#pragma unroll
    for (int t = 0; t < 16; t++) {
      float a0 = 0.f, a1 = 0.f;
#pragma unroll
      for (int j = 0; j < 5; j++) { a0 += lo2f(raw[t + j]) * wv[j].x; a1 += hi2f(raw[t + j]) * wv[j].y; }
      a0 = a0 / (1.f + __expf(-a0)); a1 = a1 / (1.f + __expf(-a1));
      if (seg < 8) {
        float ss = wave_sum(a0 * a0 + a1 * a1);
        float rn = rsqrtf(ss + 1e-6f);
        if (seg < 4) rn *= 0.08838834764831845f;
        a0 *= rn; a1 *= rn;
      }
      *(unsigned*)(dstb + (size_t)t * 512) = pk2(a0, a1);
    }
  }
  {
    size_t gtid = (size_t)blockIdx.x * 256 + TIDX, gsz = (size_t)gridDim.x * 256;
    const float* sm = (const float*)(ws + OFF_SM);
    float* gt = (float*)(ws + OFF_GT);
    for (size_t i = gtid; i < (size_t)NT * 16; i += gsz) {
      int e = (int)(i & 15), ty = e >> 2, hd = e & 3;
      float raw = sm[i], o;
      if (ty < 2) o = 1.f / (1.f + __expf(-raw));
      else {
        float al = ty == 2 ? p.in[7][hd] : p.in[8][hd];
        float db = ty == 2 ? p.in[9][hd] : p.in[10][hd];
        float x = raw + db;
        float sp = x > 20.f ? x : log1pf(__expf(x));
        o = -__expf(al) * sp;
      }
      gt[i] = o;
    }
  }
  {
    const bf16_t* att = (const bf16_t*)(ws + OFF_R6);
    bf16_t* qr = (bf16_t*)((char*)p.out + OO_QR);
    bf16_t* kr = (bf16_t*)((char*)p.out + OO_KR);
    bf16_t* vT = (bf16_t*)((char*)p.out + OO_VT);
    const float qg = p.in[12][lane], kg = p.in[13][lane];
    const int dd = lane & 31, fi = dd & 15;
    const float invf = exp2f(-(float)fi * (13.287712379549449f / 16.f));
    for (int strip = gw; strip < NT / 16; strip += nw) {
      const int tok0 = strip * 16;
      int start, T, tin0; seq_of(tok0, start, T, tin0);
#pragma unroll 2
      for (int t = 0; t < 16; t++) {
        const int tin = tin0 + t, tok = tok0 + t;
        float pos = (lane < 32) ? (float)(tin >> 6) : (float)(tin & 63);
        float ang = pos * invf;
        float cs = __cosf(ang), sn = __sinf(ang);
        const bf16_t* src = att + (size_t)tok * 768;
#pragma unroll
        for (int hh = 0; hh < 10; hh++) {
          float x = bf2f(src[hh * 64 + lane]);
          float ss = wave_sum(x * x);
          float y = x * rsqrtf(ss * (1.f / 64.f) + 1e-6f) * (hh < 8 ? qg : kg);
          float pr = __shfl_xor(y, 16);
          float o = (dd < 16) ? y * cs - pr * sn : y * cs + pr * sn;
          if (hh < 8) qr[(size_t)tok * 512 + hh * 64 + lane] = f2bf(o * (0.125f * 1.4426950408889634f));
          else kr[(size_t)tok * 128 + (hh - 8) * 64 + lane] = f2bf(o);
        }
      }
      unsigned short vv[2][16];
#pragma unroll
      for (int t = 0; t < 16; t++) {
        const bf16_t* src = att + (size_t)(tok0 + t) * 768;
        vv[0][t] = src[640 + lane]; vv[1][t] = src[704 + lane];
      }
#pragma unroll
      for (int kv = 0; kv < 2; kv++) {
        uint4 o0, o1;
        o0.x = vv[kv][0] | ((unsigned)vv[kv][1] << 16);   o0.y = vv[kv][2] | ((unsigned)vv[kv][3] << 16);
        o0.z = vv[kv][8] | ((unsigned)vv[kv][9] << 16);   o0.w = vv[kv][10] | ((unsigned)vv[kv][11] << 16);
        o1.x = vv[kv][4] | ((unsigned)vv[kv][5] << 16);   o1.y = vv[kv][6] | ((unsigned)vv[kv][7] << 16);
        o1.z = vv[kv][12] | ((unsigned)vv[kv][13] << 16); o1.w = vv[kv][14] | ((unsigned)vv[kv][15] << 16);
        bf16_t* dst = vT + (size_t)start * 128 + (size_t)(kv * 64 + lane) * T + tin0;
        *(uint4*)dst = o0; *(uint4*)(dst + 8) = o1;
      }
    }
  }
}

template <int DIR>
DI void d2_dir(const Params& p, int cidx, int head, char* lds) {
  const int wid_ = p.wid;
  char* ws = p.ws;
  float* gcs = (float*)lds;
  float* bts = gcs + 64;
  float* egs = bts + 64;
  float* Ls = egs + 64;
  bf16_t* Ks = (bf16_t*)(Ls + 64 * 68);
  bf16_t* Vs = Ks + 64 * 136;
  bf16_t* Qs = Vs + 64 * 136;
  const int tid = TIDX, lane = tid & 63, w = tid >> 6, r = lane & 31, h = lane >> 5;
  const int tok0 = cidx * 64, item = cidx * 4 + head;
  const bf16_t* qd = (const bf16_t*)(ws + OFF_R1);
  const bf16_t* kd = (const bf16_t*)(ws + OFF_R2);
  const bf16_t* vd = (const bf16_t*)(ws + OFF_R7);
  const float* gt = (const float*)(ws + OFF_GT);
  __syncthreads();
#pragma unroll
  for (int i = 0; i < 12; i++) {
    int c = tid + 256 * i, which = c >> 10, cc = c & 1023, li = cc >> 4, kc = cc & 15;
    int oi = DIR ? 63 - li : li;
    const bf16_t* sb = which == 0 ? qd : (which == 1 ? kd : vd);
    bf16_t* db = which == 0 ? Qs : (which == 1 ? Ks : Vs);
    *(uint4*)(db + li * 136 + kc * 8) = *(const uint4*)(sb + (size_t)(tok0 + oi) * 512 + head * 128 + kc * 8);
  }
  if (tid < 64) {
    int li = tid, oi = DIR ? 63 - li : li;
    float g = gt[(size_t)(tok0 + oi) * 16 + 8 + DIR * 4 + head];
    float b = gt[(size_t)(tok0 + oi) * 16 + DIR * 4 + head];
#pragma unroll
    for (int o = 1; o < 64; o <<= 1) { float t = __shfl_up(g, o); if (li >= o) g += t; }
    gcs[li] = g; bts[li] = b; egs[li] = __expf(g);
  }
  __syncthreads();
  {
    const int bi = w >> 1, bj = w & 1;
    f32x16 kk = zero16(), qk = zero16();
#pragma unroll
    for (int ks = 0; ks < 8; ks++) {
      bf16x8 kb_ = *(const bf16x8*)(Ks + (bj * 32 + r) * 136 + ks * 16 + h * 8);
      bf16x8 ka_ = *(const bf16x8*)(Ks + (bi * 32 + r) * 136 + ks * 16 + h * 8);
      bf16x8 qa_ = *(const bf16x8*)(Qs + (bi * 32 + r) * 136 + ks * 16 + h * 8);
      kk = MFMA32(ka_, kb_, kk);
      qk = MFMA32(qa_, kb_, qk);
    }
    const int j = bj * 32 + r;
    const float gj = gcs[j];
    bf16_t* Ab = (bf16_t*)(ws + OFF_R4) + ((size_t)(DIR * NITEM + item)) * 4096;
    const int oj = DIR ? 63 - j : j;
#pragma unroll
    for (int reg = 0; reg < 16; reg++) {
      int i = bi * 32 + crow(reg, h);
      float dec = __expf(fminf(gcs[i] - gj, 0.f));
      float Lv = (j < i) ? bts[i] * kk[reg] * dec : 0.f;
      Ls[i * 68 + j] = Lv;
      float Av = (j <= i) ? qk[reg] * dec : 0.f;
      int oi = DIR ? 63 - i : i;
      Ab[oi * 64 + swap23(oj)] = f2bf(Av);
    }
  }
  __syncthreads();
  f32x2 X2[32];
#pragma unroll
  for (int k = 0; k < 32; k++) { X2[k][0] = 0.f; X2[k][1] = 0.f; }
  const int c = tid;
  const bf16_t* colp = (c < 128) ? (Vs + c) : (Ks + (c - 128));
  const bool isw = c >= 128;
#pragma unroll
  for (int i = 0; i < 64; i++) {
    float eg = egs[i];
    float rhs = bf2f(colp[i * 136]) * (isw ? eg : 1.f) * bts[i];
    f32x2 acc2 = {0.f, 0.f};
#pragma unroll
    for (int j4 = 0; j4 < i; j4 += 4) {
      float4 l = *(const float4*)(Ls + i * 68 + j4);
      f32x2 la = {l.x, l.y}, lb = {l.z, l.w};
      acc2 -= la * X2[j4 >> 1];
      if (j4 + 2 < i) acc2 -= lb * X2[(j4 >> 1) + 1];
    }
    float acc = rhs + (acc2[0] + acc2[1]);
    asm volatile("" : "+v"(acc) : : "memory");
    X2[i >> 1][i & 1] = acc;
  }
#define X(k_) X2[(k_) >> 1][(k_) & 1]
  if (c < 128) {
    bf16_t* dst = (bf16_t*)(ws + (DIR ? OFF_R6 : OFF_R5)) + (size_t)item * 8192 + c * 64;
#pragma unroll
    for (int n8 = 0; n8 < 8; n8++) {
      unsigned pkd[4];
#pragma unroll
      for (int e = 0; e < 4; e++) {
        int n0 = n8 * 8 + 2 * e, n1 = n0 + 1;
        int p0 = 32 * (n0 >> 5) + (n0 & 3) + 8 * ((n0 >> 2) & 3) + 4 * ((n0 >> 4) & 1);
        int p1 = 32 * (n1 >> 5) + (n1 & 3) + 8 * ((n1 >> 2) & 3) + 4 * ((n1 >> 4) & 1);
        pkd[e] = pk2(X(DIR ? 63 - p0 : p0), X(DIR ? 63 - p1 : p1));
      }
      uint4 o; o.x = pkd[0]; o.y = pkd[1]; o.z = pkd[2]; o.w = pkd[3];
      *(uint4*)(dst + n8 * 8) = o;
    }
  } else {
    bf16_t* dst = (bf16_t*)((char*)p.out + (DIR ? OO_WB : OO_WF)) + (size_t)item * 8192 + (c - 128);
#pragma unroll
    for (int li = 0; li < 64; li++) { int oi = DIR ? 63 - li : li; dst[oi * 128] = f2bf(-X(li)); }
  }
  if (tid < 64) {
    int li = tid, oi = DIR ? 63 - li : li;
    float* gv = (float*)(ws + OFF_GV) + (size_t)(DIR * NITEM + item) * 128;
    gv[oi] = __expf(gcs[li]);
    gv[64 + oi] = __expf(gcs[63] - gcs[li]);
  }
  if (DIR == 0) {
    int pp = tid >> 1, half = tid & 1, dk = swap23(pp);
    bf16_t* dst = (bf16_t*)(ws + OFF_R3) + (size_t)item * 8192 + dk * 64 + half * 32;
#pragma unroll
    for (int n8 = 0; n8 < 4; n8++) {
      unsigned short e[8];
#pragma unroll
      for (int q = 0; q < 8; q++) { int ns = half * 32 + n8 * 8 + q; e[q] = Ks[swap23(ns) * 136 + pp]; }
      uint4 o;
      o.x = e[0] | ((unsigned)e[1] << 16); o.y = e[2] | ((unsigned)e[3] << 16);
      o.z = e[4] | ((unsigned)e[5] << 16); o.w = e[6] | ((unsigned)e[7] << 16);
      *(uint4*)(dst + n8 * 8) = o;
    }
  }
}
#undef X
DI void phase_d2(const Params& p, char* lds) {
  const int wid_ = p.wid;
  lds += *(volatile int*)(p.ws + OFF_CTR + 8);
  for (int it = blockIdx.x; it < NITEM; it += gridDim.x) {
    int cidx = it >> 2, head = it & 3;
    d2_dir<0>(p, cidx, head, lds);
    d2_dir<1>(p, cidx, head, lds);
  }
}

DI void scan_item(const Params& p, int item, char* lds) {
  const int wid_ = p.wid;
  char* ws = p.ws;
  int seq, head, dir;
  if (item < 16) { seq = 4 + (item >> 3); head = (item >> 1) & 3; dir = item & 1; }
  else { int it = item - 16; seq = it >> 3; head = (it >> 1) & 3; dir = it & 1; }
  const int T = seq < 4 ? 4096 : 16384;
  const int start = seq < 4 ? seq * 4096 : NTP + (seq - 4) * 16384;
  const int nch = T / 64, chunk0 = start / 64;
  bf16_t* Wsm = (bf16_t*)lds;
  bf16_t* Qsm = Wsm + 64 * 136;
  bf16_t* KTs = Qsm + 64 * 136;
  bf16_t* Asm = KTs + 128 * 72;
  float* gvs = (float*)(Asm + 64 * 72);
  const int tid = TIDX, lane = tid & 63, w = tid >> 6, r = lane & 31, h = lane >> 5;
  const bf16_t* Wg = (const bf16_t*)((char*)p.out + (dir ? OO_WB : OO_WF));
  const bf16_t* qd = (const bf16_t*)(ws + OFF_R1);
  const bf16_t* kTg = (const bf16_t*)(ws + OFF_R3);
  const bf16_t* Ag = (const bf16_t*)(ws + OFF_R4) + (size_t)dir * NITEM * 4096;
  const bf16_t* Ug = (const bf16_t*)(ws + (dir ? OFF_R6 : OFF_R5));
  const float* gvg = (const float*)(ws + OFF_GV) + (size_t)dir * NITEM * 128;
  bf16_t* og = (bf16_t*)(ws + (dir ? OFF_R7 : OFF_R2));
  f32x16 S[4];
#pragma unroll
  for (int t = 0; t < 4; t++) S[t] = zero16();
  uint4 pw0, pw1, pw2, pw3, pu0, pu1, pu2, pu3;
  const int r16 = tid >> 4, c16 = (tid & 15) * 8;
  const int r8 = tid >> 3, c8 = (tid & 7) * 8;
#define SCAN_PF(step_) { const int cgp_ = chunk0 + (dir ? nch - 1 - (step_) : (step_)); const size_t ip_ = (size_t)cgp_ * 4 + head; \
    const bf16_t* wp_ = Wg + ip_ * 8192 + r16 * 128 + c16; \
    pw0 = *(const uint4*)wp_; pw1 = *(const uint4*)(wp_ + 16 * 128); pw2 = *(const uint4*)(wp_ + 32 * 128); pw3 = *(const uint4*)(wp_ + 48 * 128); \
    const bf16_t* up_ = Ug + ip_ * 8192 + (size_t)(w * 32 + r) * 64 + h * 16; \
    pu0 = *(const uint4*)up_; pu1 = *(const uint4*)(up_ + 8); pu2 = *(const uint4*)(up_ + 32); pu3 = *(const uint4*)(up_ + 40); }
  SCAN_PF(0)
  for (int step = 0; step < nch; step++) {
    const int cg_ = chunk0 + (dir ? nch - 1 - step : step);
    const size_t it4 = (size_t)cg_ * 4 + head;
    *(uint4*)(Wsm + r16 * 136 + c16) = pw0; *(uint4*)(Wsm + (r16 + 16) * 136 + c16) = pw1;
    *(uint4*)(Wsm + (r16 + 32) * 136 + c16) = pw2; *(uint4*)(Wsm + (r16 + 48) * 136 + c16) = pw3;
    f32x16 vn[2];
    vn[0][0] = lo2f(pu0.x); vn[0][1] = hi2f(pu0.x); vn[0][2] = lo2f(pu0.y); vn[0][3] = hi2f(pu0.y);
    vn[0][4] = lo2f(pu0.z); vn[0][5] = hi2f(pu0.z); vn[0][6] = lo2f(pu0.w); vn[0][7] = hi2f(pu0.w);
    vn[0][8] = lo2f(pu1.x); vn[0][9] = hi2f(pu1.x); vn[0][10] = lo2f(pu1.y); vn[0][11] = hi2f(pu1.y);
    vn[0][12] = lo2f(pu1.z); vn[0][13] = hi2f(pu1.z); vn[0][14] = lo2f(pu1.w); vn[0][15] = hi2f(pu1.w);
    vn[1][0] = lo2f(pu2.x); vn[1][1] = hi2f(pu2.x); vn[1][2] = lo2f(pu2.y); vn[1][3] = hi2f(pu2.y);
    vn[1][4] = lo2f(pu2.z); vn[1][5] = hi2f(pu2.z); vn[1][6] = lo2f(pu2.w); vn[1][7] = hi2f(pu2.w);
    vn[1][8] = lo2f(pu3.x); vn[1][9] = hi2f(pu3.x); vn[1][10] = lo2f(pu3.y); vn[1][11] = hi2f(pu3.y);
    vn[1][12] = lo2f(pu3.z); vn[1][13] = hi2f(pu3.z); vn[1][14] = lo2f(pu3.w); vn[1][15] = hi2f(pu3.w);
    uint4 pq0, pq1, pq2, pq3, pk0, pk1, pk2, pk3, pa0, pa1;
    float pgv = 0.f;
    {
      const bf16_t* qp_ = qd + (size_t)(cg_ * 64 + r16) * 512 + head * 128 + c16;
      pq0 = *(const uint4*)qp_; pq1 = *(const uint4*)(qp_ + 16 * 512); pq2 = *(const uint4*)(qp_ + 32 * 512); pq3 = *(const uint4*)(qp_ + 48 * 512);
      const bf16_t* kp_ = kTg + it4 * 8192 + r8 * 64 + c8;
      pk0 = *(const uint4*)kp_; pk1 = *(const uint4*)(kp_ + 32 * 64); pk2 = *(const uint4*)(kp_ + 64 * 64); pk3 = *(const uint4*)(kp_ + 96 * 64);
      const bf16_t* ap_ = Ag + it4 * 4096 + r8 * 64 + c8;
      pa0 = *(const uint4*)ap_; pa1 = *(const uint4*)(ap_ + 32 * 64);
      if (tid < 128) pgv = gvg[it4 * 128 + tid];
    }
    __syncthreads();
#pragma unroll
    for (int t = 0; t < 4; t++) {
#pragma unroll
      for (int s = 0; s < 2; s++) {
        const bf16x8 sb = pack8(S[t], s);
        const int ks = 2 * t + s;
#pragma unroll
        for (int b = 0; b < 2; b++) {
          bf16x8 aw = *(const bf16x8*)(Wsm + (b * 32 + r) * 136 + ks * 16 + h * 8);
          vn[b] = MFMA32(aw, sb, vn[b]);
        }
      }
    }
    __builtin_amdgcn_sched_barrier(0);
    *(uint4*)(Qsm + r16 * 136 + c16) = pq0; *(uint4*)(Qsm + (r16 + 16) * 136 + c16) = pq1;
    *(uint4*)(Qsm + (r16 + 32) * 136 + c16) = pq2; *(uint4*)(Qsm + (r16 + 48) * 136 + c16) = pq3;
    *(uint4*)(KTs + r8 * 72 + c8) = pk0; *(uint4*)(KTs + (r8 + 32) * 72 + c8) = pk1;
    *(uint4*)(KTs + (r8 + 64) * 72 + c8) = pk2; *(uint4*)(KTs + (r8 + 96) * 72 + c8) = pk3;
    *(uint4*)(Asm + r8 * 72 + c8) = pa0; *(uint4*)(Asm + (r8 + 32) * 72 + c8) = pa1;
    if (tid < 128) gvs[tid] = pgv;
    __builtin_amdgcn_sched_barrier(0);
    if (step + 1 < nch) SCAN_PF(step + 1)
    __syncthreads();
    bf16x8 vb_[4];
#pragma unroll
    for (int b = 0; b < 2; b++) { vb_[2 * b] = pack8(vn[b], 0); vb_[2 * b + 1] = pack8(vn[b], 1); }
#pragma unroll
    for (int b = 0; b < 2; b++) {
      f32x16 oq = zero16();
#pragma unroll
      for (int t = 0; t < 4; t++) {
#pragma unroll
        for (int s = 0; s < 2; s++) {
          const bf16x8 sb = pack8(S[t], s);
          bf16x8 aq = *(const bf16x8*)(Qsm + (b * 32 + r) * 136 + (2 * t + s) * 16 + h * 8);
          oq = MFMA32(aq, sb, oq);
        }
      }
#pragma unroll
      for (int reg = 0; reg < 16; reg++) oq[reg] *= gvs[32 * b + crow(reg, h)];
#pragma unroll
      for (int kp = 0; kp < 4; kp++) {
        bf16x8 aa = *(const bf16x8*)(Asm + (b * 32 + r) * 72 + kp * 16 + h * 8);
        oq = MFMA32(aa, vb_[kp], oq);
      }
      {
        bf16_t* ob = og + (size_t)(cg_ * 64 + 32 * b + 4 * h) * 512 + head * 128 + w * 32 + r;
#pragma unroll
        for (int rq = 0; rq < 4; rq++) {
          bf16_t* pb_ = ob + rq * 8 * 512;
          asm volatile("" : "+v"(pb_));
#pragma unroll
          for (int r3 = 0; r3 < 4; r3++) {
            const int reg = rq * 4 + r3;
            pb_[r3 * 512] = f2bf(oq[reg]);
            vn[b][reg] *= gvs[64 + 32 * b + crow(reg, h)];
          }
        }
      }
      __builtin_amdgcn_sched_barrier(0);
    }
#pragma unroll
    for (int b = 0; b < 2; b++) { vb_[2 * b] = pack8(vn[b], 0); vb_[2 * b + 1] = pack8(vn[b], 1); }
    const float eS = gvs[dir ? 0 : 63];
#pragma unroll
    for (int t = 0; t < 4; t++) {
#pragma unroll
      for (int reg = 0; reg < 16; reg++) S[t][reg] *= eS;
#pragma unroll
      for (int kp = 0; kp < 4; kp++) {
        bf16x8 ak = *(const bf16x8*)(KTs + (t * 32 + r) * 72 + kp * 16 + h * 8);
        S[t] = MFMA32(ak, vb_[kp], S[t]);
      }
    }
  }
}

DI void attn_item(const Params& p, int seq, int kvh, int qb, int g, char* lds) {
  const int wid_ = p.wid;
  const int hh = kvh * 4 + g;
  const int T = seq < 4 ? 4096 : 16384;
  const int start = seq < 4 ? seq * 4096 : NTP + (seq - 4) * 16384;
  bf16_t* Kl = (bf16_t*)lds;
  bf16_t* Vl = Kl + 3 * 64 * 72;
  int tid = TIDX;
  asm volatile("" : "+v"(tid));
  const int lane = tid & 63, w = tid >> 6, r = lane & 31, h = lane >> 5;
  const bf16_t* qr = (const bf16_t*)((char*)p.out + OO_QR);
  const bf16_t* kbase = (const bf16_t*)((char*)p.out + OO_KR) + (size_t)start * 128 + kvh * 64;
  const bf16_t* vbase = (const bf16_t*)((char*)p.out + OO_VT) + (size_t)start * 128 + (size_t)kvh * 64 * T;
  const int qtok = start + qb * 256 + w * 64 + r;
  bf16x8 qf[2][4];
#pragma unroll
  for (int qq = 0; qq < 2; qq++)
#pragma unroll
    for (int ks = 0; ks < 4; ks++) qf[qq][ks] = *(const bf16x8*)(qr + (size_t)(qtok + 32 * qq) * 512 + hh * 64 + ks * 16 + h * 8);
  f32x16 O[2][2];
  O[0][0] = zero16(); O[0][1] = zero16(); O[1][0] = zero16(); O[1][1] = zero16();
  float lsum0 = 0.f, lsum1 = 0.f;
  uint4 rg0, rg1, rg2, rg3;
  const int ntile = T / 64;
  const int lrow = tid >> 3, lkc = (tid & 7) * 8;
#define ATT_GLOAD(kt_) { const bf16_t* kp_ = kbase + (size_t)((kt_) * 64 + lrow) * 128 + lkc; const bf16_t* vp_ = vbase + (size_t)lrow * T + (kt_) * 64 + lkc; \
    rg0 = *(const uint4*)kp_; rg1 = *(const uint4*)(kp_ + 32 * 128); rg2 = *(const uint4*)vp_; rg3 = *(const uint4*)(vp_ + (size_t)32 * T); }
#define ATT_LSTORE(buf_) { bf16_t* kd_ = Kl + (buf_) * 64 * 72 + lrow * 72 + lkc; bf16_t* vd_ = Vl + (buf_) * 64 * 72 + lrow * 72 + lkc; \
    *(uint4*)kd_ = rg0; *(uint4*)(kd_ + 32 * 72) = rg1; *(uint4*)vd_ = rg2; *(uint4*)(vd_ + 32 * 72) = rg3; }
#define ATT_QK(S0_, S1_, Kb_, kb_) { S0_ = zero16(); S1_ = zero16(); \
    _Pragma("unroll") for (int ks = 0; ks < 4; ks++) { bf16x8 a_ = *(const bf16x8*)((Kb_) + ((kb_) * 32 + r) * 72 + ks * 16 + h * 8); \
      S0_ = MFMA32(a_, qf[0][ks], S0_); S1_ = MFMA32(a_, qf[1][ks], S1_); } }
#define ATT_SPV(S0_, S1_, Vb_, kb_) { \
    _Pragma("unroll") for (int reg = 0; reg < 16; reg++) { S0_[reg] = __builtin_amdgcn_exp2f(S0_[reg]); lsum0 += S0_[reg]; S1_[reg] = __builtin_amdgcn_exp2f(S1_[reg]); lsum1 += S1_[reg]; } \
    bf16x8 p00 = pack8(S0_, 0), p01 = pack8(S0_, 1), p10 = pack8(S1_, 0), p11 = pack8(S1_, 1); \
    _Pragma("unroll") for (int db = 0; db < 2; db++) { \
      bf16x8 a0 = *(const bf16x8*)((Vb_) + (db * 32 + r) * 72 + (kb_) * 32 + h * 8); \
      bf16x8 a1 = *(const bf16x8*)((Vb_) + (db * 32 + r) * 72 + (kb_) * 32 + 16 + h * 8); \
      O[0][db] = MFMA32(a0, p00, O[0][db]); O[1][db] = MFMA32(a0, p10, O[1][db]); \
      O[0][db] = MFMA32(a1, p01, O[0][db]); O[1][db] = MFMA32(a1, p11, O[1][db]); } }
  __syncthreads();
  ATT_GLOAD(0);
  ATT_LSTORE(0);
  ATT_GLOAD(1);
  ATT_LSTORE(1);
  __syncthreads();
  f32x16 sc0, sc1, sn0, sn1;
  ATT_QK(sc0, sc1, Kl, 0)
  int bc = 0;
  for (int kt = 0; kt < ntile; kt++) {
    const int bn = bc == 2 ? 0 : bc + 1, bw = bn == 2 ? 0 : bn + 1;
    if (kt + 2 < ntile) ATT_GLOAD(kt + 2);
    const bf16_t* Kb = Kl + bc * 64 * 72;
    const bf16_t* Vb = Vl + bc * 64 * 72;
    ATT_QK(sn0, sn1, Kb, 1)
    ATT_SPV(sc0, sc1, Vb, 0)
    if (kt + 1 < ntile) { const bf16_t* Kn = Kl + bn * 64 * 72; ATT_QK(sc0, sc1, Kn, 0) }
    ATT_SPV(sn0, sn1, Vb, 1)
    if (kt + 2 < ntile) ATT_LSTORE(bw);
    __syncthreads();
    bc = bn;
  }
  float inv0 = 1.f / (lsum0 + __shfl_xor(lsum0, 32));
  float inv1 = 1.f / (lsum1 + __shfl_xor(lsum1, 32));
  {
    int tid2 = TIDX;
    asm volatile("" : "+v"(tid2));
    const int lane2 = tid2 & 63, w2 = tid2 >> 6, r2 = lane2 & 31, h2 = lane2 >> 5;
    bf16_t* mo = (bf16_t*)(p.ws + OFF_MIXATT) + (size_t)(start + qb * 256 + w2 * 64 + r2) * 512 + hh * 64 + 4 * h2;
#pragma unroll
    for (int qq = 0; qq < 2; qq++)
#pragma unroll
      for (int db = 0; db < 2; db++)
#pragma unroll
        for (int reg = 0; reg < 16; reg++) {
          int d = db * 32 + (reg & 3) + 8 * (reg >> 2);
          mo[(size_t)(32 * qq) * 512 + d] = f2bf(O[qq][db][reg] * (qq ? inv1 : inv0));
        }
  }
}
DI void phase_scan_attn(const Params& p, char* lds) {
  const int wid_ = p.wid;
  __shared__ int s_item;
  if (blockIdx.x < 48) { scan_item(p, blockIdx.x, lds); if (REPEAT_MASK & 0x10000) { __syncthreads(); scan_item(p, blockIdx.x, lds); } }
  unsigned* ctr = (unsigned*)(p.ws + OFF_CTR) + 32;
  const int g0 = blockIdx.x & 7;
  for (int k = 0; k < 8; k++) {
    const int grp = (g0 + k) & 7;
    for (;;) {
      __syncthreads();
      if (TIDX == 0) s_item = (int)atomicAdd(ctr + grp * 4, 1u);
      __syncthreads();
      const int i = s_item;
      if (i >= 192) break;
      if (i < 128) attn_item(p, 4 + (grp >> 2), (grp >> 1) & 1, 32 * (grp & 1) + (i >> 2), i & 3, lds);
      else attn_item(p, grp >> 1, grp & 1, (i - 128) >> 2, i & 3, lds);
    }
  }
}

DI void phase_d4(const Params& p) {
  const int wid_ = p.wid;
  char* ws = p.ws;
  const int lane = TIDX & 63, gw = (blockIdx.x * 256 + TIDX) >> 6, nw = gridDim.x * 4;
  const bf16_t* of = (const bf16_t*)(ws + OFF_R2);
  const bf16_t* ob = (const bf16_t*)(ws + OFF_R7);
  const bf16_t* z = (const bf16_t*)(ws + OFF_Z);
  bf16_t* mix = (bf16_t*)(ws + OFF_R3);
  const float2 gn = *(const float2*)(p.in[11] + 2 * lane);
  for (int tok = gw; tok < NT; tok += nw) {
    unsigned uf[4], ub[4], uz[4];
#pragma unroll
    for (int hd = 0; hd < 4; hd++) {
      size_t off = (size_t)tok * 512 + hd * 128 + 2 * lane;
      uf[hd] = *(const unsigned*)(of + off); ub[hd] = *(const unsigned*)(ob + off); uz[hd] = *(const unsigned*)(z + off);
    }
#pragma unroll
    for (int hd = 0; hd < 4; hd++) {
      size_t off = (size_t)tok * 512 + hd * 128 + 2 * lane;
      float o0 = lo2f(uf[hd]) + lo2f(ub[hd]), o1 = hi2f(uf[hd]) + hi2f(ub[hd]);
      float ss = wave_sum(o0 * o0 + o1 * o1);
      float rn = rsqrtf(ss * (1.f / 128.f) + 1e-6f);
      float z0 = lo2f(uz[hd]), z1 = hi2f(uz[hd]);
      float y0 = o0 * rn * gn.x * (z0 / (1.f + __expf(-z0)));
      float y1 = o1 * rn * gn.y * (z1 / (1.f + __expf(-z1)));
      *(unsigned*)(mix + off) = pk2(y0, y1);
    }
  }
}

DI void phase_gemm2(const Params& p, char* lds) {
  const int wid_ = p.wid;
  char* ws = p.ws;
  {
    const int lane = TIDX & 63, gw = (blockIdx.x * 256 + TIDX) >> 6, nw = gridDim.x * 4;
    uint4* dst = (uint4*)(ws + OFF_PTAB);
    float* scl = (float*)(ws + OFF_PTAB + 32 * MiB);
    for (int rw = gw; rw < 32768; rw += nw) {
      const float4* srow = (const float4*)((rw < 16384 ? p.in[19] : p.in[20]) + (size_t)(rw & 16383) * 1024) + 4 * lane;
      float4 v0 = srow[0], v1 = srow[1], v2 = srow[2], v3 = srow[3];
      float am = fmaxf(fmaxf(fmaxf(fabsf(v0.x), fabsf(v0.y)), fmaxf(fabsf(v0.z), fabsf(v0.w))), fmaxf(fmaxf(fabsf(v1.x), fabsf(v1.y)), fmaxf(fabsf(v1.z), fabsf(v1.w))));
      am = fmaxf(am, fmaxf(fmaxf(fmaxf(fabsf(v2.x), fabsf(v2.y)), fmaxf(fabsf(v2.z), fabsf(v2.w))), fmaxf(fmaxf(fabsf(v3.x), fabsf(v3.y)), fmaxf(fabsf(v3.z), fabsf(v3.w)))));
      am = wave_max(am);
      const float sc = am > 0.f ? 440.f / am : 1.f;
      int w0 = 0, w1 = 0, w2 = 0, w3 = 0;
      w0 = __builtin_amdgcn_cvt_pk_fp8_f32(v0.x * sc, v0.y * sc, w0, false); w0 = __builtin_amdgcn_cvt_pk_fp8_f32(v0.z * sc, v0.w * sc, w0, true);
      w1 = __builtin_amdgcn_cvt_pk_fp8_f32(v1.x * sc, v1.y * sc, w1, false); w1 = __builtin_amdgcn_cvt_pk_fp8_f32(v1.z * sc, v1.w * sc, w1, true);
      w2 = __builtin_amdgcn_cvt_pk_fp8_f32(v2.x * sc, v2.y * sc, w2, false); w2 = __builtin_amdgcn_cvt_pk_fp8_f32(v2.z * sc, v2.w * sc, w2, true);
      w3 = __builtin_amdgcn_cvt_pk_fp8_f32(v3.x * sc, v3.y * sc, w3, false); w3 = __builtin_amdgcn_cvt_pk_fp8_f32(v3.z * sc, v3.w * sc, w3, true);
      uint4 o; o.x = (unsigned)w0; o.y = (unsigned)w1; o.z = (unsigned)w2; o.w = (unsigned)w3;
      dst[(size_t)rw * 64 + lane] = o;
      if (lane == 0) scl[rw] = am > 0.f ? am * (1.f / 440.f) : 1.f;
    }
  }
  const bf16_t* mdn = (const bf16_t*)(ws + OFF_R3);
  const bf16_t* mat = (const bf16_t*)(ws + OFF_MIXATT);
  const bf16_t* wt = (const bf16_t*)(ws + OFF_WOUT);
  gemm_tiles_xcd((unsigned*)(ws + OFF_CTR) + 96, 8, NT / 256, wid_, [&](int mt, int nt) {
    const int m0 = mt * 256, n0 = nt * 128;
    gemm256(mdn + (size_t)m0 * 512, 512, mat + (size_t)m0 * 512, 512, wt + (size_t)n0 * DM, DM, DM, lds, wid_, [&](int rr, int cc, float v0, float v1) {
      int row = m0 + rr, n = n0 + cc;
      float2 xv = *(const float2*)(xrow(p, row) + n);
      *(float2*)(p.out + (size_t)row * DM + n) = make_float2(xv.x + v0, xv.y + v1);
    });
  });
}
DI void phase_norm2(const Params& p) {
  const int wid_ = p.wid;
  int lane = TIDX & 63, gw = (blockIdx.x * 256 + TIDX) >> 6, nw = gridDim.x * 4;
  bf16_t* xn = (bf16_t*)(p.ws + OFF_R1);
  for (int t = gw; t < NT; t += 2 * nw) {
    if (t + nw < NT) norm_row2_bf16(p.out + (size_t)t * DM, p.out + (size_t)(t + nw) * DM, p.in[15], xn + (size_t)t * DM, xn + (size_t)(t + nw) * DM, lane);
    else norm_row_bf16(p.out + (size_t)t * DM, p.in[15], xn + (size_t)t * DM, lane);
  }
}
DI void phase_gemm3(const Params& p, char* lds) {
  const int wid_ = p.wid;
  char* ws = p.ws;
  const bf16_t* xn = (const bf16_t*)(ws + OFF_R1);
  const bf16_t* wt = (const bf16_t*)(ws + OFF_PQW);
  bf16_t* pq = (bf16_t*)(ws + OFF_R3);
  gemm_tiles_xcd((unsigned*)(ws + OFF_CTR) + 128, 16, NT / 256, wid_, [&](int mt, int nt) {
    const int m0 = mt * 256, n0 = nt * 128;
    gemm256(xn + (size_t)m0 * DM, DM, xn, 1 << 30, wt + (size_t)n0 * DM, DM, DM, lds, wid_, [&](int rr, int cc, float v0, float v1) {
      *(unsigned*)(pq + (size_t)(m0 + rr) * 2048 + n0 + cc) = pk2(v0, v1);
    });
  });
}

#define DPP_ROR(v, n) __int_as_float(__builtin_amdgcn_update_dpp(0, __float_as_int(v), 0x120 + (n), 0xf, 0xf, true))
DI float rowmax16(float v) {
  v = fmaxf(v, DPP_ROR(v, 8)); v = fmaxf(v, DPP_ROR(v, 4)); v = fmaxf(v, DPP_ROR(v, 2)); v = fmaxf(v, DPP_ROR(v, 1));
  return v;
}
DI float rowsum16(float v) {
  v += DPP_ROR(v, 8); v += DPP_ROR(v, 4); v += DPP_ROR(v, 2); v += DPP_ROR(v, 1);
  return v;
}
__device__ const unsigned char CAND_TAB[64] = {0, 1, 2, 3, 4, 5, 6, 7, 8, 9, 10, 11, 12, 13, 14, 15, 16, 17, 18, 19, 20, 21, 22, 23, 32, 33, 34, 35, 36, 48, 49, 50, 51, 64, 65, 66, 80, 81, 96, 97, 112, 113, 128, 144, 160, 176, 192, 208, 224, 240, 255, 255, 255, 255, 255, 255, 255, 255, 255, 255, 255, 255, 255, 255};
DI void phase_topk(const Params& p, char* lds) {
  const int wid_ = p.wid;
  char* ws = p.ws;
  float* sc = (float*)lds;
  const int tid = TIDX, lane = tid & 63, w = tid >> 6, r = lane & 31, h = lane >> 5;
  const bf16_t* pq = (const bf16_t*)(ws + OFF_R3);
  const bf16_t* keys = (const bf16_t*)(ws + OFF_KEYS);
  int* pidx = (int*)(ws + OFF_R6);
  float* pgate = (float*)(ws + OFF_R6 + 24 * MiB);
  const float NEG = -3.0e38f;
  const int nblk = NT * 8 / 32;
  bf16x8 kfa[8], kfb[8], qfa[8], qfb[8];
#pragma unroll
  for (int ks = 0; ks < 8; ks++) {
    kfa[ks] = *(const bf16x8*)(keys + (w * 32 + r) * 128 + ks * 16 + h * 8);
    kfb[ks] = *(const bf16x8*)(keys + 16384 + (w * 32 + r) * 128 + ks * 16 + h * 8);
  }
  if ((int)blockIdx.x < nblk) {
#pragma unroll
    for (int ks = 0; ks < 8; ks++) {
      qfa[ks] = *(const bf16x8*)(pq + (size_t)(blockIdx.x * 32 + r) * 256 + ks * 16 + h * 8);
      qfb[ks] = *(const bf16x8*)(pq + (size_t)(blockIdx.x * 32 + r) * 256 + 128 + ks * 16 + h * 8);
    }
  }
  for (int blk = blockIdx.x; blk < nblk; blk += gridDim.x) {
    const int m0 = blk * 32;
    __syncthreads();
    {
      f32x16 sa = zero16(), sb = zero16();
#pragma unroll
      for (int ks = 0; ks < 8; ks++) {
        sa = MFMA32(qfa[ks], kfa[ks], sa);
        sb = MFMA32(qfb[ks], kfb[ks], sb);
      }
      const int nb = blk + gridDim.x;
      if (nb < nblk) {
#pragma unroll
        for (int ks = 0; ks < 8; ks++) {
          qfa[ks] = *(const bf16x8*)(pq + (size_t)(nb * 32 + r) * 256 + ks * 16 + h * 8);
          qfb[ks] = *(const bf16x8*)(pq + (size_t)(nb * 32 + r) * 256 + 128 + ks * 16 + h * 8);
        }
      }
#pragma unroll
      for (int reg = 0; reg < 16; reg++) {
        int row = crow(reg, h);
        sc[row * 132 + w * 32 + r] = sa[reg];
        sc[32 * 132 + row * 132 + w * 32 + r] = sb[reg];
      }
    }
    __syncthreads();
    {
      const int L = lane & 15, gb = lane & 48, rw0 = w * 8 + (lane >> 4);
      unsigned keep[2][2];
#define CE(x, y) { float hi_ = fmaxf(x, y), lo_ = fminf(x, y); x = hi_; y = lo_; }
#pragma unroll
      for (int side = 0; side < 2; side++) {
        float a[2][8];
#pragma unroll
        for (int q = 0; q < 2; q++) {
#pragma unroll
          for (int s = 0; s < 8; s++) {
            unsigned u = __float_as_uint(sc[side * 32 * 132 + (rw0 + 4 * q) * 132 + L + 16 * s]);
            a[q][s] = __uint_as_float((u & 0xFFFFFF80u) | (unsigned)(127 - (L + 16 * s)));
          }
          CE(a[q][0], a[q][1]) CE(a[q][2], a[q][3]) CE(a[q][4], a[q][5]) CE(a[q][6], a[q][7])
          CE(a[q][0], a[q][2]) CE(a[q][1], a[q][3]) CE(a[q][4], a[q][6]) CE(a[q][5], a[q][7])
          CE(a[q][1], a[q][2]) CE(a[q][5], a[q][6])
          CE(a[q][0], a[q][4]) CE(a[q][1], a[q][5]) CE(a[q][2], a[q][6]) CE(a[q][3], a[q][7])
          CE(a[q][2], a[q][4]) CE(a[q][3], a[q][5])
          CE(a[q][1], a[q][2]) CE(a[q][3], a[q][4]) CE(a[q][5], a[q][6])
        }
        float kp0 = 0.f, kp1 = 0.f;
        for (int it = 0; it < 16; it++) {
          float mx0 = a[0][0], mx1 = a[1][0];
          mx0 = fmaxf(mx0, DPP_ROR(mx0, 8)); mx1 = fmaxf(mx1, DPP_ROR(mx1, 8));
          mx0 = fmaxf(mx0, DPP_ROR(mx0, 4)); mx1 = fmaxf(mx1, DPP_ROR(mx1, 4));
          mx0 = fmaxf(mx0, DPP_ROR(mx0, 2)); mx1 = fmaxf(mx1, DPP_ROR(mx1, 2));
          mx0 = fmaxf(mx0, DPP_ROR(mx0, 1)); mx1 = fmaxf(mx1, DPP_ROR(mx1, 1));
          const bool w0 = a[0][0] == mx0, w1 = a[1][0] == mx1;
#pragma unroll
          for (int s = 0; s < 7; s++) { a[0][s] = w0 ? a[0][s + 1] : a[0][s]; a[1][s] = w1 ? a[1][s + 1] : a[1][s]; }
          a[0][7] = w0 ? NEG : a[0][7]; a[1][7] = w1 ? NEG : a[1][7];
          kp0 = (L == it) ? mx0 : kp0; kp1 = (L == it) ? mx1 : kp1;
        }
        keep[0][side] = __float_as_uint(kp0); keep[1][side] = __float_as_uint(kp1);
      }
      float c[2][4]; int e[2][4];
#pragma unroll
      for (int q = 0; q < 2; q++) {
#pragma unroll
        for (int s = 0; s < 4; s++) {
          const int n = s * 16 + L;
          const int ij = CAND_TAB[n];
          unsigned ua = (unsigned)__shfl((int)keep[q][0], gb + ((ij >> 4) & 15));
          unsigned ub = (unsigned)__shfl((int)keep[q][1], gb + (ij & 15));
          float v = __uint_as_float(ua & 0xFFFFFF80u) + __uint_as_float(ub & 0xFFFFFF80u);
          v = __uint_as_float((__float_as_uint(v) & 0xFFFFFFC0u) | (unsigned)(63 - n));
          c[q][s] = (ij == 255) ? NEG : v;
          e[q][s] = (127 - (int)(ua & 127u)) * 128 + (127 - (int)(ub & 127u));
        }
      }
      float cs[2][4];
#pragma unroll
      for (int q = 0; q < 2; q++) {
        cs[q][0] = c[q][0]; cs[q][1] = c[q][1]; cs[q][2] = c[q][2]; cs[q][3] = c[q][3];
        CE(cs[q][0], cs[q][1]) CE(cs[q][2], cs[q][3]) CE(cs[q][0], cs[q][2]) CE(cs[q][1], cs[q][3]) CE(cs[q][1], cs[q][2])
      }
      float ts0 = 0.f, ts1 = 0.f;
      for (int it = 0; it < 16; it++) {
        float mx0 = cs[0][0], mx1 = cs[1][0];
        mx0 = fmaxf(mx0, DPP_ROR(mx0, 8)); mx1 = fmaxf(mx1, DPP_ROR(mx1, 8));
        mx0 = fmaxf(mx0, DPP_ROR(mx0, 4)); mx1 = fmaxf(mx1, DPP_ROR(mx1, 4));
        mx0 = fmaxf(mx0, DPP_ROR(mx0, 2)); mx1 = fmaxf(mx1, DPP_ROR(mx1, 2));
        mx0 = fmaxf(mx0, DPP_ROR(mx0, 1)); mx1 = fmaxf(mx1, DPP_ROR(mx1, 1));
        const bool w0 = cs[0][0] == mx0, w1 = cs[1][0] == mx1;
#pragma unroll
        for (int s = 0; s < 3; s++) { cs[0][s] = w0 ? cs[0][s + 1] : cs[0][s]; cs[1][s] = w1 ? cs[1][s + 1] : cs[1][s]; }
        cs[0][3] = w0 ? NEG : cs[0][3]; cs[1][3] = w1 ? NEG : cs[1][3];
        ts0 = (L == it) ? mx0 : ts0; ts1 = (L == it) ? mx1 : ts1;
      }
#pragma unroll
      for (int q = 0; q < 2; q++) {
        const unsigned tu = __float_as_uint(q ? ts1 : ts0);
        const int n = 63 - (int)(tu & 63u);
        const int e0 = __shfl(e[q][0], gb + (n & 15)), e1 = __shfl(e[q][1], gb + (n & 15)), e2 = __shfl(e[q][2], gb + (n & 15)), e3 = __shfl(e[q][3], gb + (n & 15));
        const int ns = n >> 4;
        const int te = ns == 0 ? e0 : (ns == 1 ? e1 : (ns == 2 ? e2 : e3));
        const float tc = __uint_as_float(tu & 0xFFFFFFC0u);
        const float mxr = rowmax16(tc);
        const float ev = __expf(tc - mxr);
        const float sum = rowsum16(ev);
        const size_t o = (size_t)(m0 + rw0 + 4 * q) * 16 + L;
        pidx[o] = te; pgate[o] = ev / sum;
      }
    }
  }
}

typedef __attribute__((ext_vector_type(2))) float f2v;
#define FP8_DOT4(d, wq, xo) { f2v lo_ = __builtin_amdgcn_cvt_pk_f32_fp8((int)(wq), false); f2v hi_ = __builtin_amdgcn_cvt_pk_f32_fp8((int)(wq), true); \
    d = fmaf(lo_.x, xf[(xo)], d); d = fmaf(lo_.y, xf[(xo) + 1], d); d = fmaf(hi_.x, xf[(xo) + 2], d); d = fmaf(hi_.y, xf[(xo) + 3], d); }
#define FP8_AXPY4(s, wq, xo) { f2v lo_ = __builtin_amdgcn_cvt_pk_f32_fp8((int)(wq), false); f2v hi_ = __builtin_amdgcn_cvt_pk_f32_fp8((int)(wq), true); \
    acc[(xo)] = fmaf(s, lo_.x, acc[(xo)]); acc[(xo) + 1] = fmaf(s, lo_.y, acc[(xo) + 1]); acc[(xo) + 2] = fmaf(s, hi_.x, acc[(xo) + 2]); acc[(xo) + 3] = fmaf(s, hi_.y, acc[(xo) + 3]); }
DI void gather_token(const Params& p, const int tok, const int lane) {
  char* ws = p.ws;
  const uint4* ut = (const uint4*)(ws + OFF_PTAB);
  const uint4* vt = (const uint4*)(ws + OFF_PTAB + 16 * MiB);
  const float* uscl = (const float*)(ws + OFF_PTAB + 32 * MiB);
  const float* vscl = uscl + 16384;
  const int* pidx = (const int*)(ws + OFF_R6);
  const float* pgate = (const float*)(ws + OFF_R6 + 24 * MiB);
  bf16_t* xn = (bf16_t*)(ws + OFF_R1);
  {
    float xf[16];
    {
      const uint4 x0 = ((const uint4*)(xn + (size_t)tok * DM))[2 * lane];
      const uint4 x1 = ((const uint4*)(xn + (size_t)tok * DM))[2 * lane + 1];
      xf[0] = lo2f(x0.x); xf[1] = hi2f(x0.x); xf[2] = lo2f(x0.y); xf[3] = hi2f(x0.y);
      xf[4] = lo2f(x0.z); xf[5] = hi2f(x0.z); xf[6] = lo2f(x0.w); xf[7] = hi2f(x0.w);
      xf[8] = lo2f(x1.x); xf[9] = hi2f(x1.x); xf[10] = lo2f(x1.y); xf[11] = hi2f(x1.y);
      xf[12] = lo2f(x1.z); xf[13] = hi2f(x1.z); xf[14] = lo2f(x1.w); xf[15] = hi2f(x1.w);
    }
    float acc[16];
#pragma unroll
    for (int i = 0; i < 16; i++) acc[i] = 0.f;
    const int* pix = pidx + (size_t)tok * 128 + (lane >> 3);
    const float* pgt = pgate + (size_t)tok * 128 + (lane >> 3);
    int myidx = pix[0];
    float mygate = pgt[0];
    float myus = uscl[myidx], myvs = vscl[myidx];
    uint4 ur[8], vr[8];
#pragma unroll
    for (int e = 0; e < 8; e++) ur[e] = ut[(size_t)__builtin_amdgcn_readlane(myidx, e * 8) * 64 + lane];
    for (int g2 = 0; g2 < 16; g2++) {
#pragma unroll
      for (int e = 0; e < 8; e++) vr[e] = vt[(size_t)__builtin_amdgcn_readlane(myidx, e * 8) * 64 + lane];
      int nidx = myidx; float ngate = mygate, nus = myus, nvs = myvs;
      if (g2 + 1 < 16) { nidx = pix[(g2 + 1) * 8]; ngate = pgt[(g2 + 1) * 8]; nus = uscl[nidx]; nvs = vscl[nidx]; }
      float pd[8];
#pragma unroll
      for (int e = 0; e < 8; e++) {
        float d = 0.f;
        FP8_DOT4(d, ur[e].x, 0) FP8_DOT4(d, ur[e].y, 4) FP8_DOT4(d, ur[e].z, 8) FP8_DOT4(d, ur[e].w, 12)
        pd[e] = d;
      }
      if (g2 + 1 < 16) {
#pragma unroll
        for (int e = 0; e < 8; e++) ur[e] = ut[(size_t)__builtin_amdgcn_readlane(nidx, e * 8) * 64 + lane];
      }
      float q4[4];
#pragma unroll
      for (int i = 0; i < 4; i++) {
        float send = (lane & 32) ? pd[i] : pd[i + 4];
        float keep = (lane & 32) ? pd[i + 4] : pd[i];
        q4[i] = keep + __shfl_xor(send, 32);
      }
      float q2[2];
#pragma unroll
      for (int i = 0; i < 2; i++) {
        float send = (lane & 16) ? q4[i] : q4[i + 2];
        float keep = (lane & 16) ? q4[i + 2] : q4[i];
        q2[i] = keep + __shfl_xor(send, 16);
      }
      float q1;
      {
        float send = (lane & 8) ? q2[0] : q2[1];
        float keep = (lane & 8) ? q2[1] : q2[0];
        q1 = keep + __shfl_xor(send, 8);
      }
      q1 += __shfl_xor(q1, 4); q1 += __shfl_xor(q1, 2); q1 += __shfl_xor(q1, 1);
      q1 *= myus;
      const float hval = 0.5f * q1 * (1.f + erff(q1 * 0.7071067811865476f));
      const float gh = mygate * hval * myvs;
#pragma unroll
      for (int e = 0; e < 8; e++) {
        float s = __int_as_float(__builtin_amdgcn_readlane(__float_as_int(gh), e * 8));
        FP8_AXPY4(s, vr[e].x, 0) FP8_AXPY4(s, vr[e].y, 4) FP8_AXPY4(s, vr[e].z, 8) FP8_AXPY4(s, vr[e].w, 12)
      }
      myidx = nidx; mygate = ngate; myus = nus; myvs = nvs;
    }
    float4* hp = (float4*)(p.out + (size_t)tok * DM) + 4 * lane;
    float4* hq = hp;
    float4 h0 = hp[0], h1 = hp[1], h2 = hp[2], h3 = hp[3];
    h0.x += acc[0]; h0.y += acc[1]; h0.z += acc[2]; h0.w += acc[3];
    h1.x += acc[4]; h1.y += acc[5]; h1.z += acc[6]; h1.w += acc[7];
    h2.x += acc[8]; h2.y += acc[9]; h2.z += acc[10]; h2.w += acc[11];
    h3.x += acc[12]; h3.y += acc[13]; h3.z += acc[14]; h3.w += acc[15];
    hq[0] = h0; hq[1] = h1; hq[2] = h2; hq[3] = h3;
    uint4 b0, b1;
    b0.x = pk2(h0.x, h0.y); b0.y = pk2(h0.z, h0.w); b0.z = pk2(h1.x, h1.y); b0.w = pk2(h1.z, h1.w);
    b1.x = pk2(h2.x, h2.y); b1.y = pk2(h2.z, h2.w); b1.z = pk2(h3.x, h3.y); b1.w = pk2(h3.z, h3.w);
    ((uint4*)(xn + (size_t)tok * DM))[2 * lane] = b0;
    ((uint4*)(xn + (size_t)tok * DM))[2 * lane + 1] = b1;
  }
}
DI void phase_gather(const Params& p, bool dry) {
  const int wid_ = p.wid;
  char* ws = p.ws;
  const int lane = TIDX & 63, gw = (blockIdx.x * 256 + TIDX) >> 6, nw = gridDim.x * 4;
  const uint4* ut = (const uint4*)(ws + OFF_PTAB);
  const uint4* vt = (const uint4*)(ws + OFF_PTAB + 16 * MiB);
  const float* uscl = (const float*)(ws + OFF_PTAB + 32 * MiB);
  const float* vscl = uscl + 16384;
  const int* pidx = (const int*)(ws + OFF_R6);
  const float* pgate = (const float*)(ws + OFF_R6 + 24 * MiB);
  bf16_t* xn = (bf16_t*)(ws + OFF_R1);
  for (int tok = gw; tok < NT; tok += nw) {
    float xf[16];
    {
      const uint4 x0 = ((const uint4*)(xn + (size_t)tok * DM))[2 * lane];
      const uint4 x1 = ((const uint4*)(xn + (size_t)tok * DM))[2 * lane + 1];
      xf[0] = lo2f(x0.x); xf[1] = hi2f(x0.x); xf[2] = lo2f(x0.y); xf[3] = hi2f(x0.y);
      xf[4] = lo2f(x0.z); xf[5] = hi2f(x0.z); xf[6] = lo2f(x0.w); xf[7] = hi2f(x0.w);
      xf[8] = lo2f(x1.x); xf[9] = hi2f(x1.x); xf[10] = lo2f(x1.y); xf[11] = hi2f(x1.y);
      xf[12] = lo2f(x1.z); xf[13] = hi2f(x1.z); xf[14] = lo2f(x1.w); xf[15] = hi2f(x1.w);
    }
    float acc[16];
#pragma unroll
    for (int i = 0; i < 16; i++) acc[i] = 0.f;
    const int* pix = pidx + (size_t)tok * 128 + (lane >> 3);
    const float* pgt = pgate + (size_t)tok * 128 + (lane >> 3);
    int myidx = pix[0];
    float mygate = pgt[0];
    float myus = uscl[myidx], myvs = vscl[myidx];
    uint4 ur[8], vr[8];
#pragma unroll
    for (int e = 0; e < 8; e++) ur[e] = ut[(size_t)__builtin_amdgcn_readlane(myidx, e * 8) * 64 + lane];
    for (int g2 = 0; g2 < 16; g2++) {
#pragma unroll
      for (int e = 0; e < 8; e++) vr[e] = vt[(size_t)__builtin_amdgcn_readlane(myidx, e * 8) * 64 + lane];
      int nidx = myidx; float ngate = mygate, nus = myus, nvs = myvs;
      if (g2 + 1 < 16) { nidx = pix[(g2 + 1) * 8]; ngate = pgt[(g2 + 1) * 8]; nus = uscl[nidx]; nvs = vscl[nidx]; }
      float pd[8];
#pragma unroll
      for (int e = 0; e < 8; e++) {
        float d = 0.f;
        FP8_DOT4(d, ur[e].x, 0) FP8_DOT4(d, ur[e].y, 4) FP8_DOT4(d, ur[e].z, 8) FP8_DOT4(d, ur[e].w, 12)
        pd[e] = d;
      }
      if (g2 + 1 < 16) {
#pragma unroll
        for (int e = 0; e < 8; e++) ur[e] = ut[(size_t)__builtin_amdgcn_readlane(nidx, e * 8) * 64 + lane];
      }
      float q4[4];
#pragma unroll
      for (int i = 0; i < 4; i++) {
        float send = (lane & 32) ? pd[i] : pd[i + 4];
        float keep = (lane & 32) ? pd[i + 4] : pd[i];
        q4[i] = keep + __shfl_xor(send, 32);
      }
      float q2[2];
#pragma unroll
      for (int i = 0; i < 2; i++) {
        float send = (lane & 16) ? q4[i] : q4[i + 2];
        float keep = (lane & 16) ? q4[i + 2] : q4[i];
        q2[i] = keep + __shfl_xor(send, 16);
      }
      float q1;
      {
        float send = (lane & 8) ? q2[0] : q2[1];
        float keep = (lane & 8) ? q2[1] : q2[0];
        q1 = keep + __shfl_xor(send, 8);
      }
      q1 += __shfl_xor(q1, 4); q1 += __shfl_xor(q1, 2); q1 += __shfl_xor(q1, 1);
      q1 *= myus;
      const float hval = 0.5f * q1 * (1.f + erff(q1 * 0.7071067811865476f));
      const float gh = mygate * hval * myvs;
#pragma unroll
      for (int e = 0; e < 8; e++) {
        float s = __int_as_float(__builtin_amdgcn_readlane(__float_as_int(gh), e * 8));
        FP8_AXPY4(s, vr[e].x, 0) FP8_AXPY4(s, vr[e].y, 4) FP8_AXPY4(s, vr[e].z, 8) FP8_AXPY4(s, vr[e].w, 12)
      }
      myidx = nidx; mygate = ngate; myus = nus; myvs = nvs;
    }
    float4* hp = (float4*)(p.out + (size_t)tok * DM) + 4 * lane;
    float4* hq = dry ? (float4*)(ws + OFF_R3 + (size_t)tok * DM * 4) + 4 * lane : hp;
    float4 h0 = hp[0], h1 = hp[1], h2 = hp[2], h3 = hp[3];
    h0.x += acc[0]; h0.y += acc[1]; h0.z += acc[2]; h0.w += acc[3];
    h1.x += acc[4]; h1.y += acc[5]; h1.z += acc[6]; h1.w += acc[7];
    h2.x += acc[8]; h2.y += acc[9]; h2.z += acc[10]; h2.w += acc[11];
    h3.x += acc[12]; h3.y += acc[13]; h3.z += acc[14]; h3.w += acc[15];
    hq[0] = h0; hq[1] = h1; hq[2] = h2; hq[3] = h3;
    if (dry) continue;
    uint4 b0, b1;
    b0.x = pk2(h0.x, h0.y); b0.y = pk2(h0.z, h0.w); b0.z = pk2(h1.x, h1.y); b0.w = pk2(h1.z, h1.w);
    b1.x = pk2(h2.x, h2.y); b1.y = pk2(h2.z, h2.w); b1.z = pk2(h3.x, h3.y); b1.w = pk2(h3.z, h3.w);
    ((uint4*)(xn + (size_t)tok * DM))[2 * lane] = b0;
    ((uint4*)(xn + (size_t)tok * DM))[2 * lane + 1] = b1;
  }
}

DI void phase_topk_gather(const Params& p, char* lds) {
  const int wid_ = p.wid;
  char* ws = p.ws;
  float* sc = (float*)lds;
  const int tid = TIDX, lane = tid & 63, w = tid >> 6, r = lane & 31, h = lane >> 5;
  const bf16_t* pq = (const bf16_t*)(ws + OFF_R3);
  const bf16_t* keys = (const bf16_t*)(ws + OFF_KEYS);
  int* pidx = (int*)(ws + OFF_R6);
  float* pgate = (float*)(ws + OFF_R6 + 24 * MiB);
  const float NEG = -3.0e38f;
  const int nblk = NT * 8 / 32;
  __shared__ int s_fblk;
  unsigned* fctr = (unsigned*)(ws + OFF_CTR) + 224;
  int kgs = 0;
  for (;;) {
    __syncthreads();
    if (tid == 0) {
      int v_ = -1;
      while (kgs < 8) {
        const int grp_ = ((int)(blockIdx.x & 7) + kgs) & 7;
        const int u_ = (int)atomicAdd(fctr + grp_ * 4, 1u);
        if (u_ < nblk / 8) { v_ = grp_ * (nblk / 8) + u_; break; }
        kgs++;
      }
      s_fblk = v_;
    }
    __syncthreads();
    const int blk = s_fblk;
    if (blk < 0) break;
    const int m0 = blk * 32;
    {
      f32x16 sa = zero16(), sb = zero16();
#pragma unroll
      for (int ks = 0; ks < 8; ks++) {
        bf16x8 aa = *(const bf16x8*)(pq + (size_t)(m0 + r) * 256 + ks * 16 + h * 8);
        bf16x8 ab = *(const bf16x8*)(pq + (size_t)(m0 + r) * 256 + 128 + ks * 16 + h * 8);
        bf16x8 ba = *(const bf16x8*)(keys + (w * 32 + r) * 128 + ks * 16 + h * 8);
        bf16x8 bb = *(const bf16x8*)(keys + 16384 + (w * 32 + r) * 128 + ks * 16 + h * 8);
        sa = MFMA32(aa, ba, sa);
        sb = MFMA32(ab, bb, sb);
      }
#pragma unroll
      for (int reg = 0; reg < 16; reg++) {
        int row = crow(reg, h);
        sc[row * 132 + w * 32 + r] = sa[reg];
        sc[32 * 132 + row * 132 + w * 32 + r] = sb[reg];
      }
    }
    __syncthreads();
    {
      const int L = lane & 15, gb = lane & 48, rw0 = w * 8 + (lane >> 4);
      unsigned keep[2][2];
#define CE(x, y) { float hi_ = fmaxf(x, y), lo_ = fminf(x, y); x = hi_; y = lo_; }
#pragma unroll
      for (int side = 0; side < 2; side++) {
        float a[2][8];
#pragma unroll
        for (int q = 0; q < 2; q++) {
#pragma unroll
          for (int s = 0; s < 8; s++) {
            unsigned u = __float_as_uint(sc[side * 32 * 132 + (rw0 + 4 * q) * 132 + L + 16 * s]);
            a[q][s] = __uint_as_float((u & 0xFFFFFF80u) | (unsigned)(127 - (L + 16 * s)));
          }
          CE(a[q][0], a[q][1]) CE(a[q][2], a[q][3]) CE(a[q][4], a[q][5]) CE(a[q][6], a[q][7])
          CE(a[q][0], a[q][2]) CE(a[q][1], a[q][3]) CE(a[q][4], a[q][6]) CE(a[q][5], a[q][7])
          CE(a[q][1], a[q][2]) CE(a[q][5], a[q][6])
          CE(a[q][0], a[q][4]) CE(a[q][1], a[q][5]) CE(a[q][2], a[q][6]) CE(a[q][3], a[q][7])
          CE(a[q][2], a[q][4]) CE(a[q][3], a[q][5])
          CE(a[q][1], a[q][2]) CE(a[q][3], a[q][4]) CE(a[q][5], a[q][6])
        }
        float kp0 = 0.f, kp1 = 0.f;
        for (int it = 0; it < 16; it++) {
          float mx0 = a[0][0], mx1 = a[1][0];
          mx0 = fmaxf(mx0, DPP_ROR(mx0, 8)); mx1 = fmaxf(mx1, DPP_ROR(mx1, 8));
          mx0 = fmaxf(mx0, DPP_ROR(mx0, 4)); mx1 = fmaxf(mx1, DPP_ROR(mx1, 4));
          mx0 = fmaxf(mx0, DPP_ROR(mx0, 2)); mx1 = fmaxf(mx1, DPP_ROR(mx1, 2));
          mx0 = fmaxf(mx0, DPP_ROR(mx0, 1)); mx1 = fmaxf(mx1, DPP_ROR(mx1, 1));
          const bool w0 = a[0][0] == mx0, w1 = a[1][0] == mx1;
#pragma unroll
          for (int s = 0; s < 7; s++) { a[0][s] = w0 ? a[0][s + 1] : a[0][s]; a[1][s] = w1 ? a[1][s + 1] : a[1][s]; }
          a[0][7] = w0 ? NEG : a[0][7]; a[1][7] = w1 ? NEG : a[1][7];
          kp0 = (L == it) ? mx0 : kp0; kp1 = (L == it) ? mx1 : kp1;
        }
        keep[0][side] = __float_as_uint(kp0); keep[1][side] = __float_as_uint(kp1);
      }
      float c[2][4]; int e[2][4];
#pragma unroll
      for (int q = 0; q < 2; q++) {
#pragma unroll
        for (int s = 0; s < 4; s++) {
          const int n = s * 16 + L;
          const int ij = CAND_TAB[n];
          unsigned ua = (unsigned)__shfl((int)keep[q][0], gb + ((ij >> 4) & 15));
          unsigned ub = (unsigned)__shfl((int)keep[q][1], gb + (ij & 15));
          float v = __uint_as_float(ua & 0xFFFFFF80u) + __uint_as_float(ub & 0xFFFFFF80u);
          v = __uint_as_float((__float_as_uint(v) & 0xFFFFFFC0u) | (unsigned)(63 - n));
          c[q][s] = (ij == 255) ? NEG : v;
          e[q][s] = (127 - (int)(ua & 127u)) * 128 + (127 - (int)(ub & 127u));
        }
      }
      float cs[2][4];
#pragma unroll
      for (int q = 0; q < 2; q++) {
        cs[q][0] = c[q][0]; cs[q][1] = c[q][1]; cs[q][2] = c[q][2]; cs[q][3] = c[q][3];
        CE(cs[q][0], cs[q][1]) CE(cs[q][2], cs[q][3]) CE(cs[q][0], cs[q][2]) CE(cs[q][1], cs[q][3]) CE(cs[q][1], cs[q][2])
      }
      float ts0 = 0.f, ts1 = 0.f;
      for (int it = 0; it < 16; it++) {
        float mx0 = cs[0][0], mx1 = cs[1][0];
        mx0 = fmaxf(mx0, DPP_ROR(mx0, 8)); mx1 = fmaxf(mx1, DPP_ROR(mx1, 8));
        mx0 = fmaxf(mx0, DPP_ROR(mx0, 4)); mx1 = fmaxf(mx1, DPP_ROR(mx1, 4));
        mx0 = fmaxf(mx0, DPP_ROR(mx0, 2)); mx1 = fmaxf(mx1, DPP_ROR(mx1, 2));
        mx0 = fmaxf(mx0, DPP_ROR(mx0, 1)); mx1 = fmaxf(mx1, DPP_ROR(mx1, 1));
        const bool w0 = cs[0][0] == mx0, w1 = cs[1][0] == mx1;
#pragma unroll
        for (int s = 0; s < 3; s++) { cs[0][s] = w0 ? cs[0][s + 1] : cs[0][s]; cs[1][s] = w1 ? cs[1][s + 1] : cs[1][s]; }
        cs[0][3] = w0 ? NEG : cs[0][3]; cs[1][3] = w1 ? NEG : cs[1][3];
        ts0 = (L == it) ? mx0 : ts0; ts1 = (L == it) ? mx1 : ts1;
      }
#pragma unroll
      for (int q = 0; q < 2; q++) {
        const unsigned tu = __float_as_uint(q ? ts1 : ts0);
        const int n = 63 - (int)(tu & 63u);
        const int e0 = __shfl(e[q][0], gb + (n & 15)), e1 = __shfl(e[q][1], gb + (n & 15)), e2 = __shfl(e[q][2], gb + (n & 15)), e3 = __shfl(e[q][3], gb + (n & 15));
        const int ns = n >> 4;
        const int te = ns == 0 ? e0 : (ns == 1 ? e1 : (ns == 2 ? e2 : e3));
        const float tc = __uint_as_float(tu & 0xFFFFFFC0u);
        const float mxr = rowmax16(tc);
        const float ev = __expf(tc - mxr);
        const float sum = rowsum16(ev);
        const size_t o = (size_t)(m0 + rw0 + 4 * q) * 16 + L;
        pidx[o] = te; pgate[o] = ev / sum;
      }
    }
    __syncthreads();
    gather_token(p, blk * 4 + w, lane);
  }
}


DI void phase_ple_gemm(const Params& p, char* lds) {
  const int wid_ = p.wid;
  char* ws = p.ws;
  const bf16_t* pb = (const bf16_t*)(ws + OFF_PB);
  const bf16_t* hb = (const bf16_t*)(ws + OFF_R1);
  const bf16_t* wp = (const bf16_t*)(ws + OFF_PLEP);
  const bf16_t* wg = (const bf16_t*)(ws + OFF_PLEG);
  bf16_t* Pb = (bf16_t*)(ws + OFF_R3);
  bf16_t* Gb = (bf16_t*)(ws + OFF_R5);
  gemm_tiles_xcd((unsigned*)(ws + OFF_CTR) + 160, 8, NT / 256, wid_, [&](int mt, int nt) {
    const int m0 = mt * 256, n0 = nt * 128;
    gemm256(hb + (size_t)m0 * DM, DM, hb, 1 << 30, wg + (size_t)n0 * DM, DM, DM, lds, wid_, [&](int rr, int cc, float v0, float v1) {
      *(unsigned*)(Gb + (size_t)(m0 + rr) * DM + n0 + cc) = pk2(v0, v1);
    });
  });
  gemm_tiles_xcd((unsigned*)(ws + OFF_CTR) + 192, 8, NT / 256, wid_, [&](int mt, int nt) {
    const int m0 = mt * 256, n0 = nt * 128;
    gemm256(pb + (size_t)m0 * 256, 256, pb, 1 << 30, wp + (size_t)n0 * 256, 256, 256, lds, wid_, [&](int rr, int cc, float v0, float v1) {
      *(unsigned*)(Pb + (size_t)(m0 + rr) * DM + n0 + cc) = pk2(v0, v1);
    });
  });
}
DI void phase_final(const Params& p) {
  const int wid_ = p.wid;
  char* ws = p.ws;
  const int lane = TIDX & 63, gw = (blockIdx.x * 256 + TIDX) >> 6, nw = gridDim.x * 4;
  const bf16_t* Pb = (const bf16_t*)(ws + OFF_R3);
  const bf16_t* Gb = (const bf16_t*)(ws + OFF_R5);
  const float* pn = p.in[22];
  const float* fn = p.in[24];
  float pnr[16], fnr[16];
#pragma unroll
  for (int i = 0; i < 16; i++) { int d = (i >> 3) * 512 + 8 * lane + (i & 7); pnr[i] = pn[d]; fnr[i] = fn[d]; }
  for (int tok = gw; tok < NT; tok += nw) {
    float4* hp = (float4*)(p.out + (size_t)tok * DM);
    float hv[16], pv[16], gv[16];
#pragma unroll
    for (int q = 0; q < 2; q++) {
      uint4 pu = ((const uint4*)(Pb + (size_t)tok * DM))[q * 64 + lane];
      uint4 gu = ((const uint4*)(Gb + (size_t)tok * DM))[q * 64 + lane];
      float4 a = hp[q * 128 + 2 * lane], b = hp[q * 128 + 2 * lane + 1];
      hv[q * 8 + 0] = a.x; hv[q * 8 + 1] = a.y; hv[q * 8 + 2] = a.z; hv[q * 8 + 3] = a.w;
      hv[q * 8 + 4] = b.x; hv[q * 8 + 5] = b.y; hv[q * 8 + 6] = b.z; hv[q * 8 + 7] = b.w;
      pv[q * 8 + 0] = lo2f(pu.x); pv[q * 8 + 1] = hi2f(pu.x); pv[q * 8 + 2] = lo2f(pu.y); pv[q * 8 + 3] = hi2f(pu.y);
      pv[q * 8 + 4] = lo2f(pu.z); pv[q * 8 + 5] = hi2f(pu.z); pv[q * 8 + 6] = lo2f(pu.w); pv[q * 8 + 7] = hi2f(pu.w);
      gv[q * 8 + 0] = lo2f(gu.x); gv[q * 8 + 1] = hi2f(gu.x); gv[q * 8 + 2] = lo2f(gu.y); gv[q * 8 + 3] = hi2f(gu.y);
      gv[q * 8 + 4] = lo2f(gu.z); gv[q * 8 + 5] = hi2f(gu.z); gv[q * 8 + 6] = lo2f(gu.w); gv[q * 8 + 7] = hi2f(gu.w);
    }
    float ss = 0.f;
#pragma unroll
    for (int i = 0; i < 16; i++) ss += pv[i] * pv[i];
    ss = wave_sum(ss);
    float rp = rsqrtf(ss * (1.f / 1024.f) + 1e-6f);
    float s2 = 0.f;
#pragma unroll
    for (int i = 0; i < 16; i++) {
      float ple = pv[i] * rp * pnr[i];
      float sg = 1.f / (1.f + __expf(-gv[i]));
      hv[i] += ple * sg;
      s2 += hv[i] * hv[i];
    }
    s2 = wave_sum(s2);
    float rf = rsqrtf(s2 * (1.f / 1024.f) + 1e-6f);
#pragma unroll
    for (int q = 0; q < 2; q++) {
      float4 a, b;
      a.x = hv[q * 8 + 0] * rf * fnr[q * 8 + 0]; a.y = hv[q * 8 + 1] * rf * fnr[q * 8 + 1]; a.z = hv[q * 8 + 2] * rf * fnr[q * 8 + 2]; a.w = hv[q * 8 + 3] * rf * fnr[q * 8 + 3];
      b.x = hv[q * 8 + 4] * rf * fnr[q * 8 + 4]; b.y = hv[q * 8 + 5] * rf * fnr[q * 8 + 5]; b.z = hv[q * 8 + 6] * rf * fnr[q * 8 + 6]; b.w = hv[q * 8 + 7] * rf * fnr[q * 8 + 7];
      hp[q * 128 + 2 * lane] = a; hp[q * 128 + 2 * lane + 1] = b;
    }
  }
}

#define XB_TMO      128
#define XB_XCNT(j)  (256  + 64 * (j))
#define XB_XSUB(j)  (1280 + 64 * (j))
#define XB_XGEN(j)  (2304 + 64 * (j))
#define XB_TOP      3328
#define XB_TOPGEN   3392
#define XB_SPIN_CAP (1u << 24)
DI unsigned xb_ld(unsigned* q) { return __hip_atomic_load(q, __ATOMIC_RELAXED, __HIP_MEMORY_SCOPE_AGENT); }
DI unsigned xb_add(unsigned* q, unsigned v) { return __hip_atomic_fetch_add(q, v, __ATOMIC_RELAXED, __HIP_MEMORY_SCOPE_AGENT); }
DI unsigned xb_xcc_id() { return (unsigned)__builtin_amdgcn_s_getreg((3 << 11) | 20) & 0xFu; }
#define XB_SPIN(cond, bar) do { unsigned _sp = 0; while (cond) { __builtin_amdgcn_s_sleep(1); \
    if ((++_sp & 255u) == 0u) { if (xb_ld(&(bar)[XB_TMO])) break; if (_sp > XB_SPIN_CAP) { atomicAdd(&(bar)[XB_TMO], 1u); break; } } } } while (0)
DI void xcd_barrier_complete(unsigned* bar, unsigned x, unsigned& nloc, unsigned& nx) {
  const unsigned G = gridDim.x;
  unsigned sum, cnt, mine, sp = 0u;
  for (;;) {
    sum = 0u; cnt = 0u; mine = 0u;
#pragma unroll
    for (unsigned j = 0; j < 16; ++j) { const unsigned c = xb_ld(&bar[XB_XCNT(j)]); sum += c; cnt += (c > 0u) ? 1u : 0u; mine = (j == x) ? c : mine; }
    if (sum == G) break;
    __builtin_amdgcn_s_sleep(1);
    if ((++sp & 255u) == 0u) { if (xb_ld(&bar[XB_TMO])) break; if (sp > XB_SPIN_CAP) { atomicAdd(&bar[XB_TMO], 1u); break; } }
  }
  nloc = mine > 0u ? mine : 1u; nx = cnt > 0u ? cnt : 1u;
}
DI void grid_barrier(unsigned* bar, volatile unsigned* st, int wid_) {
  asm volatile("s_waitcnt vmcnt(0)" ::: "memory");
  __syncthreads();
  if (TIDX == 0) {
    const unsigned x = xb_xcc_id();
    __builtin_amdgcn_s_waitcnt(0);
    unsigned nloc = st[0], nx = st[1];
    if (nloc == 0u) { xcd_barrier_complete(bar, x, nloc, nx); st[0] = nloc; st[1] = nx; }
    const unsigned old = xb_add(&bar[XB_XSUB(x)], 1u);
    const unsigned gen = old / nloc;
    if (old + 1u == (gen + 1u) * nloc) {
      __builtin_amdgcn_fence(__ATOMIC_RELEASE, "agent");
      asm volatile("s_waitcnt vmcnt(0)" ::: "memory");
      const unsigned og = xb_add(&bar[XB_TOP], 1u);
      const unsigned tg = og / nx;
      if (og + 1u == (tg + 1u) * nx) xb_add(&bar[XB_TOPGEN], 1u);
      else XB_SPIN(xb_ld(&bar[XB_TOPGEN]) == tg, bar);
      __builtin_amdgcn_fence(__ATOMIC_ACQUIRE, "agent");
      xb_add(&bar[XB_XGEN(x)], 1u);
      asm volatile("s_waitcnt vmcnt(0)" ::: "memory");
    } else {
      XB_SPIN(xb_ld(&bar[XB_XGEN(x)]) == gen, bar);
      __builtin_amdgcn_fence(__ATOMIC_ACQUIRE, "agent");
      asm volatile("s_waitcnt vmcnt(0)" ::: "memory");
    }
  }
  __syncthreads();
}

constexpr int NPHASE = 13;
__global__ void __launch_bounds__(256, 2) hymba_fwd(Params pin) {
  extern __shared__ __attribute__((aligned(16))) char lds[];
  Params p = pin;
  p.wid = __builtin_amdgcn_readfirstlane((int)threadIdx.x >> 6);
#if MULTI_LAUNCH
#define RUN_PHASE(k, call) if (p.ph0 <= (k) && (k) < p.ph1) { call; }
#else
#ifndef REPEAT_MASK
#define REPEAT_MASK 0
#endif
#define RUN_PHASE(k, call) if (p.ph0 <= (k) && (k) < p.ph1) { call; if (((REPEAT_MASK & ~0x400) >> (k)) & 1) { __syncthreads(); call; } if ((k) + 1 < p.ph1) { grid_barrier((unsigned*)(p.ws + OFF_XB), (volatile unsigned*)&xb_words, p.wid); } }
#endif
  __shared__ uint4 xb_words;
  if (threadIdx.x == 0) xb_words = make_uint4(0u, 0u, 0u, 0u);
  __syncthreads();
  if (p.ph1 - p.ph0 > 1 && lane_id_fresh() == 0 && p.wid == 0) (void)xb_add((unsigned*)(p.ws + OFF_XB) + XB_XCNT(xb_xcc_id()), 1u);
  if (p.ph1 > 1000) cg::this_grid().sync();
  RUN_PHASE(0, phase_prep(p))
  RUN_PHASE(1, phase_gemm1(p, lds))
  RUN_PHASE(2, phase_d1(p))
  RUN_PHASE(3, phase_d2(p, lds))
  RUN_PHASE(4, phase_scan_attn(p, lds))
  RUN_PHASE(5, phase_d4(p))
  RUN_PHASE(6, phase_gemm2(p, lds))
  RUN_PHASE(7, phase_norm2(p))
  RUN_PHASE(8, phase_gemm3(p, lds))
  RUN_PHASE(9, phase_topk_gather(p, lds))
  RUN_PHASE(11, phase_ple_gemm(p, lds))
  RUN_PHASE(12, phase_final(p))
}

extern "C" void kernel_launch(void* const* d_in, const int* in_sizes, int n_in, void* d_out, int out_size, void* d_ws, size_t ws_size,
                              hipStream_t stream) {
  static int grid_blocks = 0;
  if (!grid_blocks) {
    int dev = 0, cus = 0, per_cu = 0;
    hipGetDevice(&dev);
    hipDeviceGetAttribute(&cus, hipDeviceAttributeMultiprocessorCount, dev);
    hipFuncSetAttribute((const void*)hymba_fwd, hipFuncAttributeMaxDynamicSharedMemorySize, LDS_BYTES);
    hipOccupancyMaxActiveBlocksPerMultiprocessor(&per_cu, (const void*)hymba_fwd, 256, LDS_BYTES);
    if (per_cu < 1) per_cu = 1;
    if (per_cu > 2) per_cu = 2;
    grid_blocks = cus * per_cu;
  }
  Params p{};
  for (int i = 0; i < 25; i++) p.in[i] = (const float*)d_in[i];
  p.out = (float*)d_out;
  p.ws = (char*)d_ws;
#if MULTI_LAUNCH
  for (int ph = 0; ph < NPHASE; ph++) {
    p.ph0 = ph; p.ph1 = ph + 1;
    hipLaunchKernelGGL(hymba_fwd, dim3(grid_blocks), dim3(256), LDS_BYTES, stream, p);
  }
#else
  p.ph0 = 0; p.ph1 = NPHASE;
  hipMemsetAsync((char*)d_ws + OFF_XB, 0, 3456 * 4, stream);
  void* args[] = {&p};
  hipError_t e = hipLaunchCooperativeKernel((const void*)hymba_fwd, dim3(grid_blocks), dim3(256), args, LDS_BYTES, stream);
  if (e != hipSuccess) fprintf(stderr, "cooperative launch failed: %s (grid %d)\n", hipGetErrorString(e), grid_blocks);
#endif
}
```
